# Optimizing an MI355X kernel written in HIP

```python
import math
import jax
import jax.numpy as jnp
from jax import lax
import numpy as np

D_MODEL = 1024
BATCH = 32
SEQ = 2048
DEPTH = 4

CHUNK = 64
Q_BLOCK = 128
HEAD_DIM = 64
ROPE_DIM = HEAD_DIM // 4
ROPE_THETA = 500000.0
RMS_EPS = 1e-6
A_HEADS = D_MODEL // (2 * HEAD_DIM)
A_WIDTH = A_HEADS * HEAD_DIM
B_HEADS = D_MODEL // (4 * HEAD_DIM)
B_QK_WIDTH = B_HEADS * 2 * HEAD_DIM
B_VDIM = 2 * HEAD_DIM
B_WIDTH = B_HEADS * B_VDIM
C_WIDTH = D_MODEL // 2
CONV_W = 3
D_HEADS = D_MODEL // (2 * HEAD_DIM)
D_WIDTH = D_HEADS * HEAD_DIM
D_LEFT_CHUNKS = 8
D_BAND = (D_LEFT_CHUNKS + 1) * CHUNK
REL_CLIP = 128
X_HEADS = 4
X_HEAD_DIM = D_MODEL // X_HEADS
N_MEM = 256
D_FF = 2816
N_EVEN = (DEPTH + 1) // 2
N_ODD = DEPTH // 2
EVEN_SIZES = (A_WIDTH, A_WIDTH, A_WIDTH, A_HEADS, B_QK_WIDTH, B_QK_WIDTH, B_WIDTH)
ODD_SIZES = (C_WIDTH, C_WIDTH, C_WIDTH, D_WIDTH, D_WIDTH, D_WIDTH)
EVEN_IN = 3 * A_WIDTH + A_HEADS + 2 * B_QK_WIDTH + B_WIDTH
ODD_IN = 3 * C_WIDTH + 3 * D_WIDTH
EVEN_MIX = A_WIDTH + B_WIDTH
ODD_MIX = C_WIDTH + D_WIDTH
MAX_POS_OFFSET = 65536

kernel_name = 'hybrid_fox_diff_conv_chunkattn_macaron'


def rms_norm(x, g):
    xf = x.astype(jnp.float32)
    y = xf * lax.rsqrt(jnp.mean(xf * xf, axis=-1, keepdims=True) + RMS_EPS)
    return (y * g.astype(jnp.float32)).astype(x.dtype)


def split_cols(y, sizes):
    out, start = [], 0
    for s in sizes:
        out.append(y[..., start:start + s])
        start += s
    return out


def rope_tables(positions):
    inv = ROPE_THETA ** (-jnp.arange(0, ROPE_DIM, 2, dtype=jnp.float32) / ROPE_DIM)
    ang = positions.astype(jnp.float32)[..., None] * inv
    return jnp.cos(ang), jnp.sin(ang)


def apply_partial_rope(x, cos, sin):
    half = ROPE_DIM // 2
    bshape = cos.shape[:2] + (1,) * (x.ndim - 3) + (half,)
    c, s = cos.reshape(bshape), sin.reshape(bshape)
    xr = x[..., :ROPE_DIM].astype(jnp.float32)
    x1, x2 = xr[..., :half], xr[..., half:]
    rot = jnp.concatenate([x1 * c - x2 * s, x2 * c + x1 * s], axis=-1).astype(x.dtype)
    return jnp.concatenate([rot, x[..., ROPE_DIM:]], axis=-1)


def swiglu(h, w_in, w_out):
    g, u = split_cols(h @ w_in, (D_FF, D_FF))
    return (jax.nn.silu(g) * u) @ w_out


def forgetting_attention(q, k, v, cum_logf):
    seq = q.shape[1]
    scale = q.shape[-1] ** -0.5
    outs = []
    for qs in range(0, seq, Q_BLOCK):
        qe = qs + Q_BLOCK
        s = jnp.einsum('bqhd,bkhd->bhqk', q[:, qs:qe], k[:, :qe],
                       preferred_element_type=jnp.float32) * scale
        s = s + cum_logf[:, :, qs:qe, None] - cum_logf[:, :, None, :qe]
        causal = jnp.arange(qs, qe)[:, None] >= jnp.arange(qe)[None, :]
        p = jax.nn.softmax(jnp.where(causal, s, -jnp.inf), axis=-1).astype(v.dtype)
        outs.append(jnp.einsum('bhqk,bkhd->bqhd', p, v[:, :qe]))
    return jnp.concatenate(outs, axis=1)


def differential_attention(q, k, v, lam):
    seq = q.shape[1]
    scale = q.shape[-1] ** -0.5
    outs = []
    for qs in range(0, seq, Q_BLOCK):
        qe = qs + Q_BLOCK
        s = jnp.einsum('bqhjd,bkhjd->bhjqk', q[:, qs:qe], k[:, :qe],
                       preferred_element_type=jnp.float32) * scale
        allowed = (jnp.arange(qs, qe)[:, None] // CHUNK) >= (jnp.arange(qe)[None, :] // CHUNK)
        p = jax.nn.softmax(jnp.where(allowed, s, -jnp.inf), axis=-1)
        p = (p[:, :, 0] - lam * p[:, :, 1]).astype(v.dtype)
        outs.append(jnp.einsum('bhqk,bkhe->bqhe', p, v[:, :qe]))
    return jnp.concatenate(outs, axis=1)


def short_conv_mixer(gate_b, gate_c, h, conv_w):
    u = gate_c * h
    y = lax.conv_general_dilated(u, conv_w[:, None, :], window_strides=(1,),
                                 padding=[(CONV_W - 1, 0)],
                                 dimension_numbers=('NWC', 'WIO', 'NWC'),
                                 feature_group_count=u.shape[-1])
    return gate_b * y


def chunk_band_attention(q, k, v, rel_table):
    bsz, seq, heads, hd = q.shape
    n_chunks = seq // CHUNK
    left = D_LEFT_CHUNKS * CHUNK
    pad = ((0, 0), (left, 0), (0, 0), (0, 0))
    kp, vp = jnp.pad(k, pad), jnp.pad(v, pad)
    rel = jnp.arange(CHUNK)[:, None] - jnp.arange(D_BAND)[None, :] + left
    rel_idx = jnp.clip(rel, -REL_CLIP, REL_CLIP) + REL_CLIP
    bias = rel_table[:, rel_idx].astype(jnp.float32)
    scale = hd ** -0.5

    def one_chunk(c):
        start = c * CHUNK
        qc = lax.dynamic_slice_in_dim(q, start, CHUNK, axis=1)
        kc = lax.dynamic_slice_in_dim(kp, start, D_BAND, axis=1)
        vc = lax.dynamic_slice_in_dim(vp, start, D_BAND, axis=1)
        s = jnp.einsum('bqhd,bkhd->bhqk', qc, kc, preferred_element_type=jnp.float32) * scale + bias
        valid = (start - left + jnp.arange(D_BAND)) >= 0
        p = jax.nn.softmax(jnp.where(valid, s, -jnp.inf), axis=-1).astype(v.dtype)
        return jnp.einsum('bhqk,bkhd->bqhd', p, vc)

    out = lax.map(one_chunk, jnp.arange(n_chunks))
    return out.transpose(1, 0, 2, 3, 4).reshape(bsz, seq, heads * hd)


def even_mixer(h, w_in, f_bias, qk_gains, lam_params, subln_gain, lambda_init, w_out, cos, sin):
    bsz, seq, _ = h.shape
    a_q, a_k, a_v, a_f, b_q, b_k, b_v = split_cols(h @ w_in, EVEN_SIZES)
    aq = rms_norm(a_q.reshape(bsz, seq, A_HEADS, HEAD_DIM), qk_gains[0])
    ak = rms_norm(a_k.reshape(bsz, seq, A_HEADS, HEAD_DIM), qk_gains[1])
    av = a_v.reshape(bsz, seq, A_HEADS, HEAD_DIM)
    logf = jax.nn.log_sigmoid((a_f + f_bias).astype(jnp.float32))
    cum_logf = jnp.cumsum(logf, axis=1).transpose(0, 2, 1)
    a_out = forgetting_attention(aq, ak, av, cum_logf).reshape(bsz, seq, A_WIDTH)
    bq = rms_norm(b_q.reshape(bsz, seq, B_HEADS, 2, HEAD_DIM), qk_gains[2])
    bk = rms_norm(b_k.reshape(bsz, seq, B_HEADS, 2, HEAD_DIM), qk_gains[3])
    bq, bk = apply_partial_rope(bq, cos, sin), apply_partial_rope(bk, cos, sin)
    bv = b_v.reshape(bsz, seq, B_HEADS, B_VDIM)
    lp = lam_params.astype(jnp.float32)
    lam = jnp.exp(jnp.sum(lp[0] * lp[1])) - jnp.exp(jnp.sum(lp[2] * lp[3])) + lambda_init
    b_out = differential_attention(bq, bk, bv, lam)
    b_out = (rms_norm(b_out, subln_gain) * (1.0 - lambda_init)).reshape(bsz, seq, B_WIDTH)
    return jnp.concatenate([a_out, b_out], axis=-1) @ w_out


def odd_mixer(h, w_in, conv_w, qk_gains, rel_table, w_out):
    bsz, seq, _ = h.shape
    c_b, c_c, c_h, d_q, d_k, d_v = split_cols(h @ w_in, ODD_SIZES)
    c_out = short_conv_mixer(c_b, c_c, c_h, conv_w)
    dq = rms_norm(d_q.reshape(bsz, seq, D_HEADS, HEAD_DIM), qk_gains[0])
    dk = rms_norm(d_k.reshape(bsz, seq, D_HEADS, HEAD_DIM), qk_gains[1])
    dv = d_v.reshape(bsz, seq, D_HEADS, HEAD_DIM)
    d_out = chunk_band_attention(dq, dk, dv, rel_table)
    return jnp.concatenate([c_out, d_out], axis=-1) @ w_out


def memory_cross_attention(h, mem_n, w_q, w_kv, qk_gains, w_o):
    bsz, seq, _ = h.shape
    q = rms_norm((h @ w_q).reshape(bsz, seq, X_HEADS, X_HEAD_DIM), qk_gains[0])
    k, v = split_cols(mem_n @ w_kv, (D_MODEL, D_MODEL))
    k = rms_norm(k.reshape(bsz, -1, X_HEADS, X_HEAD_DIM), qk_gains[1])
    v = v.reshape(bsz, -1, X_HEADS, X_HEAD_DIM)
    s = jnp.einsum('bqhd,bkhd->bhqk', q, k, preferred_element_type=jnp.float32) * X_HEAD_DIM ** -0.5
    p = jax.nn.softmax(s, axis=-1).astype(v.dtype)
    o = jnp.einsum('bhqk,bkhd->bqhd', p, v).reshape(bsz, seq, D_MODEL)
    return o @ w_o


def setup_inputs(seed: int = 0) -> dict:
    key = jax.random.key(seed)
    ks = jax.random.split(key, 24)
    f32 = jnp.float32

    def dense(k, shape):
        return jax.random.normal(k, shape, f32) * shape[-2] ** -0.5

    def gain(k, shape):
        return 1.0 + 0.05 * jax.random.normal(k, shape, f32)

    x = jax.random.normal(ks[0], (BATCH, SEQ, D_MODEL), f32)
    mem = jax.random.normal(ks[1], (BATCH, N_MEM, D_MODEL), f32)
    offset = jax.random.randint(ks[2], (BATCH, 1), 0, MAX_POS_OFFSET, dtype=jnp.int32)
    positions = offset + jnp.arange(SEQ, dtype=jnp.int32)[None, :]
    return {
        'x': x,
        'mem': mem,
        'positions': positions,
        'ln_gains': gain(ks[3], (DEPTH, 5, D_MODEL)),
        'ffn1_w_in': dense(ks[4], (DEPTH, D_MODEL, 2 * D_FF)),
        'ffn1_w_out': dense(ks[5], (DEPTH, D_FF, D_MODEL)),
        'ffn2_w_in': dense(ks[6], (DEPTH, D_MODEL, 2 * D_FF)),
        'ffn2_w_out': dense(ks[7], (DEPTH, D_FF, D_MODEL)),
        'even_w_in': dense(ks[8], (N_EVEN, D_MODEL, EVEN_IN)),
        'even_f_bias': jax.random.uniform(ks[9], (N_EVEN, A_HEADS), f32, 1.0, 5.0),
        'even_qk_gains': gain(ks[10], (N_EVEN, 4, HEAD_DIM)),
        'even_lambda': 0.1 * jax.random.normal(ks[11], (N_EVEN, 4, HEAD_DIM), f32),
        'even_subln_gain': gain(ks[12], (N_EVEN, B_VDIM)),
        'even_w_out': dense(ks[13], (N_EVEN, EVEN_MIX, D_MODEL)),
        'odd_w_in': dense(ks[14], (N_ODD, D_MODEL, ODD_IN)),
        'odd_conv_w': jax.random.normal(ks[15], (N_ODD, CONV_W, C_WIDTH), f32) * CONV_W ** -0.5,
        'odd_qk_gains': gain(ks[16], (N_ODD, 2, HEAD_DIM)),
        'odd_rel_bias': 0.5 * jax.random.normal(ks[17], (N_ODD, D_HEADS, 2 * REL_CLIP + 1), f32),
        'odd_w_out': dense(ks[18], (N_ODD, ODD_MIX, D_MODEL)),
        'x_w_q': dense(ks[19], (DEPTH, D_MODEL, D_MODEL)),
        'x_w_kv': dense(ks[20], (DEPTH, D_MODEL, 2 * D_MODEL)),
        'x_qk_gains': gain(ks[21], (DEPTH, 2, X_HEAD_DIM)),
        'x_w_o': dense(ks[22], (DEPTH, D_MODEL, D_MODEL)),
    }


def reference(x, mem, positions, ln_gains, ffn1_w_in, ffn1_w_out, ffn2_w_in, ffn2_w_out,
              even_w_in, even_f_bias, even_qk_gains, even_lambda, even_subln_gain, even_w_out,
              odd_w_in, odd_conv_w, odd_qk_gains, odd_rel_bias, odd_w_out,
              x_w_q, x_w_kv, x_qk_gains, x_w_o):
    cos, sin = rope_tables(positions)
    for layer in range(DEPTH):
        g = ln_gains[layer]
        x = x + 0.5 * swiglu(rms_norm(x, g[0]), ffn1_w_in[layer], ffn1_w_out[layer])
        h = rms_norm(x, g[1])
        if layer % 2 == 0:
            e = layer // 2
            lambda_init = 0.8 - 0.6 * math.exp(-0.3 * layer)
            mixed = even_mixer(h, even_w_in[e], even_f_bias[e], even_qk_gains[e], even_lambda[e],
                               even_subln_gain[e], lambda_init, even_w_out[e], cos, sin)
        else:
            o = layer // 2
            mixed = odd_mixer(h, odd_w_in[o], odd_conv_w[o], odd_qk_gains[o], odd_rel_bias[o],
                              odd_w_out[o])
        x = x + mixed
        x = x + memory_cross_attention(rms_norm(x, g[2]), rms_norm(mem, g[3]), x_w_q[layer],
                                       x_w_kv[layer], x_qk_gains[layer], x_w_o[layer])
        x = x + 0.5 * swiglu(rms_norm(x, g[4]), ffn2_w_in[layer], ffn2_w_out[layer])
    return x
```

```cpp
#include <hip/hip_runtime.h>
#include <hip/hip_cooperative_groups.h>
#include <cstdio>
#include <cstdint>
#include <cmath>
#define MK_SINGLE 1
namespace pg8 {
#define PG8_LAS __attribute__((address_space(3)))
typedef unsigned short bf16_t;
typedef short bf16x8 __attribute__((ext_vector_type(8)));
typedef float f32x4 __attribute__((ext_vector_type(4)));
typedef unsigned u32x4 __attribute__((ext_vector_type(4)));
constexpr int BM = 256, BK = 64, HALF = 128, HTB = HALF * BK * 2  , STAGE_BYTES = 8 * HTB, NXCD = 8, WGM = 8;

__host__ __device__ __forceinline__ int lds_byte(int r, int c) { const int st = (r >> 4) * 2 + (c >> 5), rr = r & 15, cc = c & 31, ob = rr * 64 + cc * 2; return st * 1024 + (ob ^ (((ob >> 9) & 1) << 5)); }
__host__ __device__ __forceinline__ void stage_rc(int b, int& R, int& C) { const int st = b / 1024, sb = b % 1024, swz = sb ^ (((sb >> 9) & 1) << 5); R = (st >> 1) * 16 + swz / 64; C = (st & 1) * 32 + (swz % 64) / 2; }
__host__ __device__ __forceinline__ int perm32(int rho) { const int n = rho >> 4, i = rho & 15; return 8 * (i >> 2) + 4 * n + (i & 3); }

struct Unit { int pm, pn; };
struct Gemm { const bf16_t* A; const bf16_t* Bt; int M, N, K; };

struct StaticOrder {
    int nM, nN, nwg, G, c;
    __host__ __device__ void init(int M, int N, int G_, int c_) { nM = M / BM; nN = N / BM; nwg = nM * nN; G = G_; c = c_; }
    __host__ __device__ bool next(int i, Unit& u) const {
        const long L = (long)i * G + c; if (L >= nwg) return false;
        int wgid = (int)L; { const int q = nwg / NXCD, r = nwg % NXCD, xcd = wgid % NXCD, off = wgid / NXCD; wgid = (xcd < r ? xcd * (q + 1) : r * (q + 1) + (xcd - r) * q) + off; }
        const int nig = WGM * nN, gid = wgid / nig, fm = gid * WGM, gsz = (nM - fm) < WGM ? (nM - fm) : WGM;
        u.pm = fm + ((wgid % nig) % gsz); u.pn = (wgid % nig) / gsz; return true;
    }
    __device__ __forceinline__ void a_ready(const Unit&) const {}
    __device__ __forceinline__ void done(const Unit&) const {}
};

__device__ __forceinline__ unsigned cvt_pk_bf16(float lo, float hi) { unsigned r; asm volatile("v_cvt_pk_bf16_f32 %0, %1, %2" : "=v"(r) : "v"(lo), "v"(hi)); return r; }
typedef float f32x2 __attribute__((ext_vector_type(2)));

typedef unsigned u32x2 __attribute__((ext_vector_type(2)));
typedef _Float16 f16x8v __attribute__((ext_vector_type(8)));
__device__ __forceinline__ float bf2f(unsigned v) { return __uint_as_float(v << 16); }
__device__ __forceinline__ float row_rs(const float* SSP, int row) {
    const f32x4* p = (const f32x4*)(SSP + (size_t)row * 16); const f32x4 a = p[0], b = p[1], c = p[2], d = p[3];
    const float s = (((a[0] + a[1]) + (a[2] + a[3])) + ((b[0] + b[1]) + (b[2] + b[3]))) + (((c[0] + c[1]) + (c[2] + c[3])) + ((d[0] + d[1]) + (d[2] + d[3])));
    return rsqrtf(s * (1.0f / 1024.0f) + 1e-6f);
}

struct EpiSwiglu {
    static constexpr bool PERM = true, AFTER_DRAIN = false;
    bf16_t* H; const float* SS;
    mutable float rsv[2][4]; mutable int last_pm;
    __device__ __forceinline__ void operator()(const f32x4 (&acc)[2][2][4][2], const Unit& u, int wr, int wc, int fr, int fq) const {
        const int row0 = u.pm * BM + wr * 64 + fr; const int col0 = u.pn * 128 + wc * 32 + 8 * fq;
        if (u.pm != last_pm) {
            last_pm = u.pm;
#pragma unroll
            for (int ai = 0; ai < 2; ++ai)
#pragma unroll
                for (int m = 0; m < 4; ++m) rsv[ai][m] = row_rs(SS, row0 + ai * HALF + m * 16);
        }
#pragma unroll
        for (int ai = 0; ai < 2; ++ai)
#pragma unroll
            for (int m = 0; m < 4; ++m) {
                const int row = row0 + ai * HALF + m * 16;
                const float rs = rsv[ai][m];
                unsigned w[4];
#pragma unroll
                for (int n = 0; n < 2; ++n) {
                    const f32x4 g = acc[ai][0][m][n] * rs, uu = acc[ai][1][m][n] * rs; float hv[4];
#pragma unroll
                    for (int j = 0; j < 4; ++j) { const float e = __expf(-g[j]); hv[j] = g[j] * __builtin_amdgcn_rcpf(1.0f + e) * uu[j]; }
                    w[2 * n] = cvt_pk_bf16(hv[0], hv[1]); w[2 * n + 1] = cvt_pk_bf16(hv[2], hv[3]);
                }
                *(u32x4*)(H + (size_t)row * 2816 + col0) = (u32x4){w[0], w[1], w[2], w[3]};
            }
    }
};

typedef _Float16 f16x4 __attribute__((ext_vector_type(4)));
typedef _Float16 f16x8 __attribute__((ext_vector_type(8)));
struct EpiResid {
    static constexpr bool PERM = true, AFTER_DRAIN = false;
    const _Float16* xin; _Float16* xout; bf16_t* XB; float* SSn; float alpha; float* outf;
    __device__ __forceinline__ void operator()(const f32x4 (&acc)[2][2][4][2], const Unit& u, int wr, int wc, int fr, int fq) const {
        const int row0 = u.pm * BM + wr * 64 + fr; const int col0 = u.pn * BM + wc * 32 + 8 * fq;
        f16x8 xhv[2][4][2];
#pragma unroll
        for (int ai = 0; ai < 2; ++ai)
#pragma unroll
            for (int m = 0; m < 4; ++m)
#pragma unroll
                for (int bj = 0; bj < 2; ++bj) xhv[ai][m][bj] = *(const f16x8*)(xin + (size_t)(row0 + ai * HALF + m * 16) * 1024 + col0 + bj * HALF);
#pragma unroll
        for (int ai = 0; ai < 2; ++ai) {
#pragma unroll
            for (int m = 0; m < 4; ++m) {
                const int row = row0 + ai * HALF + m * 16; const size_t off = (size_t)row * 1024 + col0; float ss = 0.f;
#pragma unroll
                for (int bj = 0; bj < 2; ++bj) {
                    const size_t o = off + bj * HALF;
                    const f16x8 xh = xhv[ai][m][bj];
                    const f32x4 x0 = (f32x4){(float)xh[0], (float)xh[1], (float)xh[2], (float)xh[3]} + acc[ai][bj][m][0] * alpha;
                    const f32x4 x1 = (f32x4){(float)xh[4], (float)xh[5], (float)xh[6], (float)xh[7]} + acc[ai][bj][m][1] * alpha;
                    if (outf) { *(f32x4*)(outf + o) = x0; *(f32x4*)(outf + o + 4) = x1; }
                    else {
                        *(f16x8*)(xout + o) = (f16x8){(_Float16)x0[0], (_Float16)x0[1], (_Float16)x0[2], (_Float16)x0[3], (_Float16)x1[0], (_Float16)x1[1], (_Float16)x1[2], (_Float16)x1[3]};
                        ss += ((x0[0] * x0[0] + x0[1] * x0[1]) + (x0[2] * x0[2] + x0[3] * x0[3])) + ((x1[0] * x1[0] + x1[1] * x1[1]) + (x1[2] * x1[2] + x1[3] * x1[3]));
                    }
                }
                if (!outf) { ss += __shfl_xor(ss, 16); ss += __shfl_xor(ss, 32);
                    if (fq == 0) SSn[(size_t)row * 16 + u.pn * 4 + wc] = ss; }
            }
        }
    }
};

struct EpiProj {
    static constexpr bool PERM = true, AFTER_DRAIN = false;
    bf16_t* P; int ldp; const float* SS; int nP; bf16_t* VT; int tsh; int cwsh;
    mutable float rsv[2][4]; mutable int last_pm;
    __device__ __forceinline__ void operator()(const f32x4 (&acc)[2][2][4][2], const Unit& u, int wr, int wc, int fr, int fq) const {
        const int row0 = u.pm * BM + wr * 64 + fr;
        if (u.pm != last_pm) {
            last_pm = u.pm;
#pragma unroll
            for (int ai = 0; ai < 2; ++ai)
#pragma unroll
                for (int m = 0; m < 4; ++m) rsv[ai][m] = row_rs(SS, row0 + ai * HALF + m * 16);
        }
        if (u.pn < nP) {
            const int col0 = u.pn * BM + wc * 32 + 8 * fq;
#pragma unroll
            for (int ai = 0; ai < 2; ++ai)
#pragma unroll
                for (int m = 0; m < 4; ++m) {
                    const int row = row0 + ai * HALF + m * 16;
                    const float rs = rsv[ai][m];
                    bf16_t* rowp = P + (size_t)row * ldp + col0;
#pragma unroll
                    for (int bj = 0; bj < 2; ++bj) {
                        const f32x4 v0 = acc[ai][bj][m][0] * rs, v1 = acc[ai][bj][m][1] * rs;
                        u32x4 w; w.x = cvt_pk_bf16(v0[0], v0[1]); w.y = cvt_pk_bf16(v0[2], v0[3]); w.z = cvt_pk_bf16(v1[0], v1[1]); w.w = cvt_pk_bf16(v1[2], v1[3]);
                        *(u32x4*)(rowp + bj * HALF) = w;
                    }
                }
        } else {
            const int T = 1 << tsh, CWm = (1 << cwsh) - 1;
            const int ccb = (u.pn - nP) * BM + wc * 32 + 8 * fq;
#pragma unroll
            for (int ai = 0; ai < 2; ++ai)
#pragma unroll
                for (int m = 0; m < 4; ++m) {
                    const int row = row0 + ai * HALF + m * 16;
                    const float rs = rsv[ai][m];
                    const int b = row >> tsh, t = row & (T - 1);
                    const int odd = fr & 1, te = t & ~1;
#pragma unroll
                    for (int bj = 0; bj < 2; ++bj)
#pragma unroll
                        for (int n = 0; n < 2; ++n)
#pragma unroll
                            for (int jp = 0; jp < 2; ++jp) {
                                const float va = acc[ai][bj][m][n][2 * jp] * rs, vb = acc[ai][bj][m][n][2 * jp + 1] * rs;
                                const float give = odd ? va : vb;
                                const float got = __builtin_bit_cast(float, __builtin_amdgcn_update_dpp(0, __builtin_bit_cast(int, give), 0xB1, 0xF, 0xF, true));
                                const int j = 2 * jp + odd;
                                const unsigned w = odd ? cvt_pk_bf16(got, vb) : cvt_pk_bf16(va, got);
                                const int cc = ccb + bj * HALF + 4 * n + j;
                                const size_t o = ((size_t)((((cc >> cwsh) * 32 + b) << cwsh) + (cc & CWm)) << tsh) + te;
                                *(unsigned*)(VT + o) = w;
                            }
                }
        }
    }
};
template <class Epi, class Sched, bool ALIGN_EPI = false, bool SP2 = false, bool F16 = false>
__device__ __forceinline__ void gemm_phase(PG8_LAS unsigned char* lds, const Gemm g, const Sched& S, const Epi& E) {
    int tid_raw_ = threadIdx.x; asm volatile("" : "+v"(tid_raw_));
    const int tid = tid_raw_, wid = __builtin_amdgcn_readfirstlane(tid >> 6), lane = tid & 63, wr = wid >> 2, wc = wid & 3, fr = lane & 15, fq = lane >> 4;
    const int K = g.K, nt = K / BK;
    unsigned voffA[2], voffB[2];
#pragma unroll
    for (int i = 0; i < 2; ++i) { int R, C; stage_rc(tid * 16 + i * 8192, R, C); const int Rb = Epi::PERM ? ((R & ~31) + perm32(R & 31)) : R;
        voffA[i] = (unsigned)(R * K + C) * 2u; voffB[i] = (unsigned)(Rb * K + C) * 2u; }
    const size_t kstep = (size_t)(BK * 2);
    const size_t hstep = (size_t)HALF * K * 2;
    const size_t tstep = 2 * hstep;
    const unsigned ldsw = (unsigned)wid * 1024u;
    const int aoff = lds_byte(wr * 64 + fr, fq * 8), boff = lds_byte(wc * 32 + fr, fq * 8);
#define PG8_SA(b, h) (((b) * 2 + (h)) * HTB)
#define PG8_SB(b, h) ((4 + (b) * 2 + (h)) * HTB)
#define PG8_STAGE(bufoff, gbase, voff) do { _Pragma("unroll") for (int _i = 0; _i < 2; ++_i) \
        __builtin_amdgcn_global_load_lds((const unsigned*)((const char*)(gbase) + (voff)[_i]), (PG8_LAS unsigned*)(lds + (bufoff) + ldsw + _i * 8192), 16, 0, 0); } while (0)
#define PG8_LDA(dst, b, h) do { _Pragma("unroll") for (int m = 0; m < 4; ++m) _Pragma("unroll") for (int k = 0; k < 2; ++k) dst[m][k] = *(const PG8_LAS bf16x8*)(lds + PG8_SA(b, h) + aoff + m * 2048 + k * 1024); } while (0)
#define PG8_LDB(dst, b, h) do { _Pragma("unroll") for (int n = 0; n < 2; ++n) _Pragma("unroll") for (int k = 0; k < 2; ++k) dst[n][k] = *(const PG8_LAS bf16x8*)(lds + PG8_SB(b, h) + boff + n * 2048 + k * 1024); } while (0)
#define PG8_MMA(ai, bj, At, Bt) do { __builtin_amdgcn_s_setprio(1); _Pragma("unroll") for (int m = 0; m < 4; ++m) _Pragma("unroll") for (int n = 0; n < 2; ++n) _Pragma("unroll") for (int k = 0; k < 2; ++k) \
        acc[ai][bj][m][n] = F16 ? __builtin_amdgcn_mfma_f32_16x16x32_f16(__builtin_bit_cast(f16x8v, Bt[n][k]), __builtin_bit_cast(f16x8v, At[m][k]), acc[ai][bj][m][n], 0, 0, 0) : __builtin_amdgcn_mfma_f32_16x16x32_bf16(Bt[n][k], At[m][k], acc[ai][bj][m][n], 0, 0, 0); __builtin_amdgcn_s_setprio(0); } while (0)
#define PG8_WAIT_V(n) asm volatile("s_waitcnt vmcnt(" #n ")" ::: "memory")
#define PG8_WAIT_L(n) asm volatile("s_waitcnt lgkmcnt(" #n ")" ::: "memory")
#define PG8_BAR __builtin_amdgcn_s_barrier()
#define PG8_SCHED __builtin_amdgcn_sched_barrier(0)
    Unit cur, nxt; int ui = 0;
    if (!S.next(0, cur)) return;
    f32x4 acc[2][2][4][2];
#pragma unroll
    for (int a = 0; a < 2; ++a)
#pragma unroll
        for (int b = 0; b < 2; ++b)
#pragma unroll
            for (int m = 0; m < 4; ++m)
#pragma unroll
                for (int n = 0; n < 2; ++n) acc[a][b][m][n] = (f32x4){0.f, 0.f, 0.f, 0.f};
    bf16x8 At[4][2], B0[2][2], B1[2][2];
    const char* cA = (const char*)g.A + (size_t)cur.pm * tstep; const char* cB = (const char*)g.Bt + (size_t)cur.pn * tstep;
    S.a_ready(cur);
    if constexpr (SP2) {
        PG8_STAGE(PG8_SB(0, 0), cB, voffB); PG8_STAGE(PG8_SB(0, 1), cB + hstep, voffB); PG8_STAGE(PG8_SA(0, 0), cA, voffA); PG8_STAGE(PG8_SA(0, 1), cA + hstep, voffA);
        if (wr == 1) PG8_BAR;
        PG8_WAIT_V(2); PG8_BAR;
        PG8_STAGE(PG8_SB(1, 0), cB + kstep, voffB); PG8_STAGE(PG8_SA(1, 0), cA + kstep, voffA); PG8_STAGE(PG8_SB(1, 1), cB + hstep + kstep, voffB);
        PG8_WAIT_V(6); PG8_BAR;
    } else {
        PG8_STAGE(PG8_SB(0, 0), cB, voffB); PG8_STAGE(PG8_SA(0, 0), cA, voffA); PG8_STAGE(PG8_SB(0, 1), cB + hstep, voffB); PG8_STAGE(PG8_SA(0, 1), cA + hstep, voffA);
        if (wr == 1) PG8_BAR;
        PG8_WAIT_V(4); PG8_BAR;
        PG8_STAGE(PG8_SB(1, 0), cB + kstep, voffB); PG8_STAGE(PG8_SA(1, 0), cA + kstep, voffA); PG8_STAGE(PG8_SB(1, 1), cB + hstep + kstep, voffB);
        PG8_WAIT_V(6); PG8_BAR;
    }
    for (;;) {
        const bool has_next = S.next(ui + 1, nxt);
        const char* nA = has_next ? (const char*)g.A + (size_t)nxt.pm * tstep : cA; const char* nB = has_next ? (const char*)g.Bt + (size_t)nxt.pn * tstep : cB;
        for (int t = 0; t < nt; t += 2) {
            const bool last = (t == nt - 2);
            const char* a1 = cA + (size_t)(t + 1) * kstep;
            const char* a2 = last ? nA : cA + (size_t)(t + 2) * kstep; const char* b2 = last ? nB : cB + (size_t)(t + 2) * kstep;
            const char* a3 = a2 + kstep; const char* b3 = b2 + kstep;
            if (last && has_next) S.a_ready(nxt);
            if constexpr (SP2) {
            PG8_LDB(B0, 0, 0); PG8_LDB(B1, 0, 1); PG8_SCHED; PG8_LDA(At, 0, 0); PG8_STAGE(PG8_SA(1, 1), a1 + hstep, voffA);
            PG8_WAIT_V(8); PG8_WAIT_L(0); PG8_BAR; PG8_MMA(0, 0, At, B0); PG8_MMA(0, 1, At, B1); PG8_BAR; PG8_SCHED;
            PG8_LDA(At, 0, 1); PG8_STAGE(PG8_SB(0, 0), b2, voffB); PG8_STAGE(PG8_SB(0, 1), b2 + hstep, voffB); PG8_STAGE(PG8_SA(0, 0), a2, voffA);
            PG8_WAIT_V(8); PG8_WAIT_L(0); PG8_BAR; PG8_MMA(1, 0, At, B0); PG8_MMA(1, 1, At, B1); PG8_BAR; PG8_SCHED;
            PG8_LDB(B0, 1, 0); PG8_LDB(B1, 1, 1); PG8_SCHED; PG8_LDA(At, 1, 0); PG8_STAGE(PG8_SA(0, 1), a2 + hstep, voffA);
            PG8_WAIT_V(8); PG8_WAIT_L(0); PG8_BAR; PG8_MMA(0, 0, At, B0); PG8_MMA(0, 1, At, B1); PG8_BAR; PG8_SCHED;
            PG8_LDA(At, 1, 1); PG8_STAGE(PG8_SB(1, 0), b3, voffB); PG8_STAGE(PG8_SB(1, 1), b3 + hstep, voffB); PG8_STAGE(PG8_SA(1, 0), a3, voffA);
            PG8_WAIT_V(8); PG8_WAIT_L(0); PG8_BAR; PG8_MMA(1, 0, At, B0); PG8_MMA(1, 1, At, B1); PG8_BAR; PG8_SCHED;
            } else {
            PG8_LDB(B0, 0, 0); PG8_SCHED; PG8_LDA(At, 0, 0); PG8_STAGE(PG8_SA(1, 1), a1 + hstep, voffA);
            PG8_WAIT_L(8); PG8_BAR; PG8_WAIT_L(0); PG8_MMA(0, 0, At, B0); PG8_BAR; PG8_SCHED;
            PG8_LDB(B1, 0, 1); PG8_STAGE(PG8_SB(0, 0), b2, voffB);
            PG8_BAR; PG8_WAIT_L(0); PG8_MMA(0, 1, At, B1); PG8_BAR;
            PG8_LDA(At, 0, 1); PG8_STAGE(PG8_SA(0, 0), a2, voffA);
            PG8_BAR; PG8_WAIT_L(0); PG8_MMA(1, 0, At, B0); PG8_BAR; PG8_SCHED;
            PG8_STAGE(PG8_SB(0, 1), b2 + hstep, voffB);
            PG8_WAIT_V(6); PG8_BAR; PG8_MMA(1, 1, At, B1); PG8_BAR;
            PG8_LDB(B0, 1, 0); PG8_SCHED; PG8_LDA(At, 1, 0); PG8_STAGE(PG8_SA(0, 1), a2 + hstep, voffA);
            PG8_WAIT_L(8); PG8_BAR; PG8_WAIT_L(0); PG8_MMA(0, 0, At, B0); PG8_BAR; PG8_SCHED;
            PG8_LDB(B1, 1, 1); PG8_STAGE(PG8_SB(1, 0), b3, voffB);
            PG8_BAR; PG8_WAIT_L(0); PG8_MMA(0, 1, At, B1); PG8_BAR;
            PG8_LDA(At, 1, 1); PG8_STAGE(PG8_SA(1, 0), a3, voffA);
            PG8_BAR; PG8_WAIT_L(0); PG8_MMA(1, 0, At, B0); PG8_BAR; PG8_SCHED;
            PG8_STAGE(PG8_SB(1, 1), b3 + hstep, voffB);
            PG8_WAIT_V(6); PG8_BAR; PG8_MMA(1, 1, At, B1); PG8_BAR;
            }
        }
        if constexpr (ALIGN_EPI) { if (wr == 0) PG8_BAR; }
        if constexpr (!Epi::AFTER_DRAIN) { E(acc, cur, wr, wc, fr, fq); S.done(cur); }
        if (!has_next) break;
#pragma unroll
        for (int a = 0; a < 2; ++a)
#pragma unroll
            for (int b = 0; b < 2; ++b)
#pragma unroll
                for (int m = 0; m < 4; ++m)
#pragma unroll
                    for (int n = 0; n < 2; ++n) acc[a][b][m][n] = (f32x4){0.f, 0.f, 0.f, 0.f};
        cur = nxt; cA = nA; cB = nB; ++ui;
        if constexpr (ALIGN_EPI) { if (wr == 1) PG8_BAR; }
    }
    PG8_WAIT_V(0);
    if constexpr (!ALIGN_EPI) { if (wr == 0) PG8_BAR; }
    PG8_BAR;
    if constexpr (Epi::AFTER_DRAIN) { E.fused(acc, cur, wr, wc, fr, fq, lds, wid, lane); S.done(cur); }
#undef PG8_SA
#undef PG8_SB
#undef PG8_STAGE
#undef PG8_LDA
#undef PG8_LDB
#undef PG8_MMA
#undef PG8_WAIT_V
#undef PG8_WAIT_L
#undef PG8_BAR
#undef PG8_SCHED
}
}

namespace att {
#define LAS __attribute__((address_space(3)))
typedef unsigned short bf16_t;
typedef short bf16x8 __attribute__((ext_vector_type(8)));
typedef float f32x16 __attribute__((ext_vector_type(16)));
typedef float f32x4 __attribute__((ext_vector_type(4)));
typedef unsigned u32x4 __attribute__((ext_vector_type(4)));
typedef _Float16 f16x8 __attribute__((ext_vector_type(8)));
constexpr float LOG2E = 1.4426950408889634f;
constexpr float NEG_BIG = -1.0e30f;
__device__ __forceinline__ int pi32(int m) { return (m & 0x13) | ((m & 4) << 1) | ((m & 8) >> 1); }
__device__ __forceinline__ unsigned cvtpk(float lo, float hi) { unsigned r; asm volatile("v_cvt_pk_bf16_f32 %0, %1, %2" : "=v"(r) : "v"(lo), "v"(hi)); return r; }
__device__ __forceinline__ float bflo(unsigned w) { return __uint_as_float(w << 16); }
__device__ __forceinline__ float bfhi(unsigned w) { return __uint_as_float(w & 0xffff0000u); }
__device__ __forceinline__ void unpack8(const u32x4 r, float (&x)[8]) {
    x[0] = bflo(r.x); x[1] = bfhi(r.x); x[2] = bflo(r.y); x[3] = bfhi(r.y); x[4] = bflo(r.z); x[5] = bfhi(r.z); x[6] = bflo(r.w); x[7] = bfhi(r.w);
}
__device__ __forceinline__ u32x4 pack8(const float (&x)[8]) { u32x4 w; w.x = cvtpk(x[0], x[1]); w.y = cvtpk(x[2], x[3]); w.z = cvtpk(x[4], x[5]); w.w = cvtpk(x[6], x[7]); return w; }

template <int DK, int NDB, int NSPLIT, int TK = 64> struct Cfg {
    static constexpr int NPB = (NDB == 2) ? 2 : 1;
    static constexpr int KS = DK * 2 + 16, KBUF = TK * KS, DVT = 32 * NDB * NSPLIT, VSB = TK * 2 + 16, VBUF = DVT * VSB, XOFF = 2 * NPB * (KBUF + VBUF);
    static constexpr int PPR = DK / 8, RPI = 512 / PPR, NKL = TK / RPI;
    static constexpr int PV = TK / 8, RVI = 512 / PV, NVL = DVT / RVI;
    static constexpr int NSB = TK / 32, NKS = TK / 16;
};

template <int DK, int NDB, int NSPLIT, int MODE, int TK>
__device__ __forceinline__ void attn_core(LAS unsigned char* lds, const int tid,
        const bf16_t* Qrow, const LAS float* gq, const LAS float* gk,
        const bf16_t* Kbase, const int kpitch, const bf16_t* VTbase, const int vtpitch,
        const int kt0, const int kt1, const int wlo, const int whi, const int diag,
        const int qidx, const float* CSq, const _Float16* CSk, const int dsplit, const bool bounded,
        f32x16 (&O)[NDB], float& lsum_out) {
    typedef Cfg<DK, NDB, NSPLIT, TK> C;
    const int lane = tid & 63, hi = lane >> 5, q31 = lane & 31, pim = pi32(q31);
    bf16x8 qf[DK / 16];
#define ATT_QPROLOGUE() do { \
        u32x4 qraw_[DK / 16]; \
        _Pragma("unroll") for (int d0 = 0; d0 < DK / 16; ++d0) qraw_[d0] = *(const u32x4*)(Qrow + 16 * d0 + 8 * hi); \
        f32x4 cq_[4]; \
        if (MODE == 1) { _Pragma("unroll") for (int i_ = 0; i_ < 4; ++i_) cq_[i_] = *(const f32x4*)(CSq + 4 * i_); } \
        float ss = 0.f; \
        _Pragma("unroll") for (int d0 = 0; d0 < DK / 16; ++d0) { float x[8]; unpack8(qraw_[d0], x); \
            _Pragma("unroll") for (int e = 0; e < 8; ++e) ss += x[e] * x[e]; } \
        ss += __shfl_xor(ss, 32); \
        const float rs = rsqrtf(ss * (1.0f / DK) + 1e-6f) * (rsqrtf((float)DK) * LOG2E); \
        _Pragma("unroll") for (int d0 = 0; d0 < DK / 16; ++d0) { float x[8]; unpack8(qraw_[d0], x); \
            const f32x4 g0 = *(const LAS f32x4*)(gq + 16 * d0 + 8 * hi), g1 = *(const LAS f32x4*)(gq + 16 * d0 + 8 * hi + 4); \
            _Pragma("unroll") for (int e = 0; e < 4; ++e) { x[e] *= rs * g0[e]; x[4 + e] *= rs * g1[e]; } \
            if (MODE == 1 && d0 == 0) { \
                _Pragma("unroll") for (int e = 0; e < 8; ++e) { const float xp = __shfl_xor(x[e], 32); const float c = cq_[e >> 2][e & 3], sn = cq_[2 + (e >> 2)][e & 3]; x[e] = hi ? (x[e] * c + xp * sn) : (x[e] * c - xp * sn); } \
            } \
            const u32x4 w = pack8(x); qf[d0] = __builtin_bit_cast(bf16x8, w); } \
    } while (0)
    const int kpiece = tid % C::PPR, krow = tid / C::PPR, vpiece = tid % C::PV, vrow = tid / C::PV;
    const unsigned koff = (unsigned)(krow * kpitch * 2 + kpiece * 16), voff = (unsigned)(vrow * vtpitch * 2 + vpiece * 16);
    const unsigned klds = (unsigned)(krow * C::KS + kpiece * 16), vlds = (unsigned)(2 * C::NPB * C::KBUF + vrow * C::VSB + vpiece * 16);
    constexpr bool DEEP = (C::NPB == 2);
    constexpr int NP = DEEP ? 2 : 1;
    constexpr int PVB = (NDB <= 2) ? 2 : 1, KFB = (MODE == 1) ? 2 : 4;
    u32x4 kr[NP][C::NKL], vr[NP][C::NVL];
#define ATT_GLD(dst, ptr) do { dst = *(const u32x4*)(ptr); } while (0)
#define ATT_LOAD(st, kt) do { \
    _Pragma("unroll") for (int i_ = 0; i_ < C::NKL; ++i_) { const char* kbp_ = (const char*)(Kbase + (size_t)((kt) * TK + i_ * C::RPI) * kpitch); ATT_GLD(kr[st][i_], kbp_ + koff); } \
    _Pragma("unroll") for (int i_ = 0; i_ < C::NVL; ++i_) { const char* vbp_ = (const char*)(VTbase + (size_t)(i_ * C::RVI) * vtpitch + (kt) * TK); ATT_GLD(vr[st][i_], vbp_ + voff); } } while (0)
#define ATT_WAIT(st, newer) do { } while (0)
#define ATT_STORE(st, kt, buf) do { \
    _Pragma("unroll") for (int i_ = 0; i_ < C::NKL; ++i_) { *(LAS u32x4*)(lds + (buf) * C::KBUF + i_ * C::RPI * C::KS + klds) = kr[st][i_]; } \
    _Pragma("unroll") for (int i_ = 0; i_ < C::NVL; ++i_) { *(LAS u32x4*)(lds + (buf) * C::VBUF + i_ * C::RVI * C::VSB + vlds) = vr[st][i_]; } } while (0)

#pragma unroll
    for (int db = 0; db < NDB; ++db)
#pragma unroll
        for (int r = 0; r < 16; ++r) O[db][r] = 0.f;
    constexpr float THR = 16.0f;
    constexpr bool LMFMA = (NDB <= 2);
    float lsum = 0.f;
    f32x16 lacc;
    if (LMFMA) {
#pragma unroll
        for (int r = 0; r < 16; ++r) lacc[r] = 0.f;
    }
    const bf16x8 onesf = {(short)0x3F80, (short)0x3F80, (short)0x3F80, (short)0x3F80, (short)0x3F80, (short)0x3F80, (short)0x3F80, (short)0x3F80};
    float Fq = 0.f;
    if (MODE == 0) Fq = ((const LAS float*)(lds + C::XOFF))[qidx];
    f32x16 cinit;
    float moff = 0.f;
    if (MODE == 0) {
#pragma unroll
        for (int r = 0; r < 16; ++r) cinit[r] = Fq;
    }
    ATT_LOAD(0, kt0);
    if (DEEP) ATT_LOAD(1, kt0 + 1);
    ATT_QPROLOGUE();
    ATT_STORE(0, kt0, 0);
    if (DEEP) ATT_STORE(1, kt0 + 1, 1);
    __syncthreads();
    int cur = 0;
#pragma unroll 1
    for (int kt2 = kt0; kt2 < kt1; kt2 += NP) {
#pragma unroll
      for (int p = 0; p < NP; ++p) {
        const int kt = kt2 + p;
        if (kt < kt1) {
        const bool more = DEEP ? (kt2 + 2 < kt1) : (kt + 1 < kt1);
        if (DEEP && p == 0 && more) { ATT_LOAD(0, kt2 + 2); ATT_LOAD(1, kt2 + 3); }
        if (MODE == 1 && more) ATT_LOAD(0, kt + 1);
        if (kt >= wlo && kt <= whi) {
            const LAS unsigned char* kb = lds + (cur * NP + p) * C::KBUF + pim * C::KS + hi * 16;
            f32x16 s[C::NSB];
#pragma unroll
            for (int dg = 0; dg < DK / (16 * KFB); ++dg) {
                bf16x8 kf[C::NSB][KFB];
#pragma unroll
                for (int dd = 0; dd < KFB; ++dd)
#pragma unroll
                    for (int sb = 0; sb < C::NSB; ++sb) kf[sb][dd] = *(const LAS bf16x8*)(kb + sb * 32 * C::KS + (dg * KFB + dd) * 32);
                __builtin_amdgcn_sched_barrier(0);
                __builtin_amdgcn_s_setprio(1);
#pragma unroll
                for (int dd = 0; dd < KFB; ++dd)
#pragma unroll
                    for (int sb = 0; sb < C::NSB; ++sb) {
                        const int d0 = dg * KFB + dd;
                        if (d0 == 0) { if (MODE == 0) s[sb] = __builtin_amdgcn_mfma_f32_32x32x16_bf16(kf[sb][dd], qf[d0], cinit, 0, 0, 0);
                                       else { f32x16 z;
#pragma unroll
                                              for (int r = 0; r < 16; ++r) z[r] = 0.f;
                                              s[sb] = __builtin_amdgcn_mfma_f32_32x32x16_bf16(kf[sb][dd], qf[d0], z, 0, 0, 0); } }
                        else s[sb] = __builtin_amdgcn_mfma_f32_32x32x16_bf16(kf[sb][dd], qf[d0], s[sb], 0, 0, 0);
                    }
                __builtin_amdgcn_s_setprio(0);
                __builtin_amdgcn_sched_barrier(0);
            }
            if (MODE == 3 && more) { ATT_LOAD(0, kt + 1); __builtin_amdgcn_sched_barrier(0); }
            if (MODE == 0) {
                const LAS float* Fl = (const LAS float*)(lds + C::XOFF);
                const int kb0 = kt * TK + 8 * hi;
#pragma unroll
                for (int sb = 0; sb < C::NSB; ++sb)
#pragma unroll
                    for (int a = 0; a < 2; ++a) {
                        const f32x4 f0 = *(const LAS f32x4*)(Fl + kb0 + 32 * sb + 16 * a), f1 = *(const LAS f32x4*)(Fl + kb0 + 32 * sb + 16 * a + 4);
#pragma unroll
                        for (int e = 0; e < 4; ++e) { s[sb][8 * a + e] -= f0[e]; s[sb][8 * a + 4 + e] -= f1[e]; }
                    }
                if (kt == diag) {
#pragma unroll
                    for (int sb = 0; sb < C::NSB; ++sb)
#pragma unroll
                        for (int r = 0; r < 16; ++r) { const int key = kb0 + 32 * sb + 16 * (r >> 3) + (r & 7); if (key > qidx) s[sb][r] = NEG_BIG; }
                }
            }
            if (MODE == 2) {
                const LAS float* tab = (const LAS float*)(lds + C::XOFF);
                if (kt + 2 >= diag) {
                    const int rel0 = qidx - (kt * TK + 8 * hi);
#pragma unroll
                    for (int sb = 0; sb < C::NSB; ++sb)
#pragma unroll
                        for (int r = 0; r < 16; ++r) { const int rel = rel0 - (32 * sb + 16 * (r >> 3) + (r & 7));
                            const int i0 = min(max(rel, -128), 128) + 128; s[sb][r] += tab[i0]; }
                } else {
                    const float c = tab[256];
#pragma unroll
                    for (int sb = 0; sb < C::NSB; ++sb)
#pragma unroll
                        for (int r = 0; r < 16; ++r) s[sb][r] += c;
                }
            }
            if (!bounded) {
                if (MODE != 0 && __any(moff != 0.f)) {
#pragma unroll
                    for (int sb = 0; sb < C::NSB; ++sb)
#pragma unroll
                        for (int r = 0; r < 16; ++r) s[sb][r] -= moff;
                }
                float mx = fmaxf(fmaxf(s[0][0], s[0][1]), s[0][2]);
#pragma unroll
                for (int sb = 0; sb < C::NSB; ++sb)
#pragma unroll
                    for (int r = (sb == 0 ? 3 : 0); r + 1 < 16; r += 2) mx = fmaxf(fmaxf(mx, s[sb][r]), s[sb][r + 1]);
                mx = fmaxf(mx, s[0][15]);
                mx = fmaxf(mx, __shfl_xor(mx, 32));
                if (__any(mx > THR)) {
                    const float dl = fmaxf(mx, 0.f), f = __builtin_amdgcn_exp2f(-dl);
#pragma unroll
                    for (int sb = 0; sb < C::NSB; ++sb)
#pragma unroll
                        for (int r = 0; r < 16; ++r) s[sb][r] -= dl;
                    if (MODE == 0) {
#pragma unroll
                        for (int r = 0; r < 16; ++r) cinit[r] -= dl;
                    } else moff += dl;
                    lsum *= f;
                    if (LMFMA) {
#pragma unroll
                        for (int r = 0; r < 16; ++r) lacc[r] *= f;
                    }
#pragma unroll
                    for (int db = 0; db < NDB; ++db)
#pragma unroll
                        for (int r = 0; r < 16; ++r) O[db][r] *= f;
                }
            }
            if (LMFMA) {
#pragma unroll
                for (int sb = 0; sb < C::NSB; ++sb)
#pragma unroll
                    for (int r = 0; r < 16; ++r) s[sb][r] = __builtin_amdgcn_exp2f(s[sb][r]);
            } else {
                float ps = 0.f;
#pragma unroll
                for (int sb = 0; sb < C::NSB; ++sb)
#pragma unroll
                    for (int r = 0; r < 16; ++r) { s[sb][r] = __builtin_amdgcn_exp2f(s[sb][r]); ps += s[sb][r]; }
                lsum += ps;
            }
            const LAS unsigned char* vb = lds + 2 * NP * C::KBUF + (cur * NP + p) * C::VBUF + (dsplit * 32 * NDB + pim) * C::VSB + hi * 16;
#pragma unroll
            for (int kg = 0; kg < C::NKS / PVB; ++kg) {
                bf16x8 vf[PVB][NDB];
#pragma unroll
                for (int k2 = 0; k2 < PVB; ++k2)
#pragma unroll
                    for (int db = 0; db < NDB; ++db) vf[k2][db] = *(const LAS bf16x8*)(vb + db * 32 * C::VSB + (PVB * kg + k2) * 32);
                u32x4 pw[PVB];
#pragma unroll
                for (int k2 = 0; k2 < PVB; ++k2) { const int ks = PVB * kg + k2, sb = ks >> 1, r0 = 8 * (ks & 1);
                    pw[k2].x = cvtpk(s[sb][r0 + 0], s[sb][r0 + 1]); pw[k2].y = cvtpk(s[sb][r0 + 2], s[sb][r0 + 3]); pw[k2].z = cvtpk(s[sb][r0 + 4], s[sb][r0 + 5]); pw[k2].w = cvtpk(s[sb][r0 + 6], s[sb][r0 + 7]); }
                __builtin_amdgcn_sched_barrier(0);
                __builtin_amdgcn_s_setprio(1);
#pragma unroll
                for (int k2 = 0; k2 < PVB; ++k2)
#pragma unroll
                    for (int db = 0; db < NDB; ++db)
                        O[db] = __builtin_amdgcn_mfma_f32_32x32x16_bf16(vf[k2][db], __builtin_bit_cast(bf16x8, pw[k2]), O[db], 0, 0, 0);
                if (LMFMA) {
#pragma unroll
                    for (int k2 = 0; k2 < PVB; ++k2) lacc = __builtin_amdgcn_mfma_f32_32x32x16_bf16(onesf, __builtin_bit_cast(bf16x8, pw[k2]), lacc, 0, 0, 0);
                }
                __builtin_amdgcn_s_setprio(0);
                __builtin_amdgcn_sched_barrier(0);
            }
        }
        if (DEEP) { if (p == 1) { if (more) { ATT_STORE(0, kt2 + 2, (cur ^ 1) * 2); ATT_STORE(1, kt2 + 3, (cur ^ 1) * 2 + 1); } __syncthreads(); cur ^= 1; } }
        else { if (more) ATT_STORE(0, kt + 1, cur ^ 1); __syncthreads(); cur ^= 1; }
        }
      }
    }
    if (LMFMA) lsum = lacc[0];
    else lsum += __shfl_xor(lsum, 32);
    lsum_out = lsum;
#undef ATT_LOAD
#undef ATT_GLD
#undef ATT_WAIT
#undef ATT_STORE
#undef ATT_QPROLOGUE
}

template <int NDB>
__device__ __forceinline__ void store_o(bf16_t* orow, const f32x16 (&O)[NDB], const float inv, const int hi) {
#pragma unroll
    for (int db = 0; db < NDB; ++db)
#pragma unroll
        for (int a = 0; a < 2; ++a) {
            u32x4 w; w.x = cvtpk(O[db][8 * a + 0] * inv, O[db][8 * a + 1] * inv); w.y = cvtpk(O[db][8 * a + 2] * inv, O[db][8 * a + 3] * inv);
            w.z = cvtpk(O[db][8 * a + 4] * inv, O[db][8 * a + 5] * inv); w.w = cvtpk(O[db][8 * a + 6] * inv, O[db][8 * a + 7] * inv);
            *(u32x4*)(orow + 32 * db + 16 * a + 8 * hi) = w;
        }
}
}
__device__ __forceinline__ float bf2f_u(unsigned short v) { return __uint_as_float((unsigned)v << 16); }

namespace cg = cooperative_groups;
#ifndef MK_SINGLE
#define MK_SINGLE 1
#endif
typedef unsigned short bf16;
typedef unsigned v4u __attribute__((ext_vector_type(4)));
typedef float f32x4 __attribute__((ext_vector_type(4)));
constexpr int NWAVES = 8, NTHREADS = 512;
constexpr int DM = 1024, NB = 32, SEQ = 2048, M = NB * SEQ, DEPTH = 4, DFF = 2816, NMEM = 256, MMEM = NB * NMEM;
constexpr int PP = 2560;
constexpr size_t MiB = 1u << 20;
constexpr size_t WS_SS = 1 * MiB, WS_SSMEM = 6 * MiB, WS_CS = 7 * MiB, WS_CSH = 11 * MiB, WS_W = 16 * MiB;
constexpr int GOFF = 143360;
constexpr size_t W_LAYER = 45 * MiB + MiB / 2;
constexpr size_t WO_1IN = 0, WO_1OUT = 11 * MiB, WO_2IN = 16 * MiB + MiB / 2, WO_2OUT = 27 * MiB + MiB / 2, WO_MIXIN = 33 * MiB, WO_MIXOUT = 39 * MiB + MiB / 2, WO_XQ = 41 * MiB + MiB / 2, WO_XO = 43 * MiB + MiB / 2;
constexpr size_t WS_WKV = WS_W + 4 * W_LAYER;
constexpr size_t WS_XB = 216 * MiB, WS_MEMB = 344 * MiB, WS_KX = 360 * MiB, WS_VXT = 376 * MiB, WS_R1 = 392 * MiB;
constexpr size_t WS_H = WS_R1, WS_P = WS_R1, WS_VT = WS_R1 + 320 * MiB, WS_OMIX = WS_VT + 128 * MiB, WS_QX = WS_R1, WS_OX = WS_R1 + 128 * MiB;
constexpr size_t WS_STASH = WS_OMIX + 128 * MiB;
constexpr size_t WS_END = WS_STASH + 32 * MiB;
static_assert(WS_WKV + 16 * MiB <= WS_XB && WS_H + (size_t)M * DFF * 2 <= WS_STASH && WS_P + (size_t)M * PP * 2 <= WS_VT, "ws map");
constexpr int LDS_BYTES = 147456;

struct Args {
    const float* in[23]; float* out; unsigned char* ws; double inv[8]; int ph_lo, ph_hi, zero_alpha, pad;
};

#define LDS_WAIT() asm volatile("s_waitcnt lgkmcnt(0)" ::: "memory")
__device__ __forceinline__ unsigned f2bf(float f) { unsigned u = __builtin_bit_cast(unsigned, f); return (u + 0x7fffu + ((u >> 16) & 1u)) >> 16; }
__device__ __forceinline__ unsigned pk2(float lo, float hi) { return f2bf(lo) | (f2bf(hi) << 16); }
__device__ __forceinline__ float wave_sum(float v) {
#pragma unroll
    for (int o = 1; o < 64; o <<= 1) v += __shfl_xor(v, o);
    return v;
}

__device__ __forceinline__ unsigned pkh2(float lo, float hi) { typedef _Float16 h2 __attribute__((ext_vector_type(2))); const h2 v = {(_Float16)lo, (_Float16)hi}; return __builtin_bit_cast(unsigned, v); }
__device__ __forceinline__ void p0_item_map(int it, int nnb, int Nsrc, int maptype, int& k0, int& n0, int& srcc0, int& nvalid) {
    const int kb = it / nnb, nb = it % nnb; k0 = kb * 64; n0 = nb * 32; srcc0 = n0; nvalid = 32;
    if (maptype == 0) { nvalid = Nsrc - n0; nvalid = nvalid < 0 ? 0 : (nvalid > 32 ? 32 : nvalid); }
    else if (maptype == 1) { const int tile = n0 >> 8, r = n0 & 255; srcc0 = (r < 128) ? tile * 128 + r : DFF + tile * 128 + (r - 128); }
    else {
        if (n0 < 1024) srcc0 = n0;
        else if (n0 < 2048) srcc0 = 1544 + (n0 - 1024);
        else if (n0 < 2304) { srcc0 = 1536 + (n0 - 2048); nvalid = (n0 == 2048) ? 8 : 0; if (nvalid == 0) srcc0 = 0; }
        else if (n0 < 2816) srcc0 = 1024 + (n0 - 2304);
        else srcc0 = 2568 + (n0 - 2816);
    }
}
__device__ __forceinline__ void p0_item_load(const float* W, int Nsrc, int k0, int srcc0, int nvalid, int lane, f32x4 (&wv)[8]) {
    const int c4 = lane & 7, r8 = lane >> 3;
#pragma unroll
    for (int i = 0; i < 8; ++i) { const int kk = 8 * i + r8;
        wv[i] = (4 * c4 < nvalid) ? *(const f32x4*)(W + (size_t)(k0 + kk) * Nsrc + srcc0 + 4 * c4) : (f32x4){0.f, 0.f, 0.f, 0.f}; }
}
__device__ __forceinline__ void p0_item_finish(const f32x4 (&wv)[8], int K, bf16* WT, int n0, const float* gain, LAS float* scr, int k0, int lane, bool f16) {
    const float gl = gain ? gain[k0 + lane] : 1.0f;
    const int c4 = lane & 7, r8 = lane >> 3;
#pragma unroll
    for (int i = 0; i < 8; ++i) { const int kk = 8 * i + r8; const float gk_ = __shfl(gl, kk); LAS float* d = scr + kk * 33 + 4 * c4;
        d[0] = wv[i][0] * gk_; d[1] = wv[i][1] * gk_; d[2] = wv[i][2] * gk_; d[3] = wv[i][3] * gk_; }
    LDS_WAIT();
    const int c8 = lane & 7;
#pragma unroll
    for (int j = 0; j < 4; ++j) { const int n = (lane >> 3) + 8 * j; const LAS float* s = scr + (8 * c8) * 33 + n;
        v4u o;
        if (f16) { o.x = pkh2(s[0 * 33], s[1 * 33]); o.y = pkh2(s[2 * 33], s[3 * 33]); o.z = pkh2(s[4 * 33], s[5 * 33]); o.w = pkh2(s[6 * 33], s[7 * 33]); }
        else { o.x = pk2(s[0 * 33], s[1 * 33]); o.y = pk2(s[2 * 33], s[3 * 33]); o.z = pk2(s[4 * 33], s[5 * 33]); o.w = pk2(s[6 * 33], s[7 * 33]); }
        *(v4u*)(WT + (size_t)(n0 + n) * K + k0 + 8 * c8) = o; }
    LDS_WAIT();
}

__device__ __forceinline__ void p0_matrix(const float* W, int K, int Nsrc, bf16* WT, int Ndst, int maptype, const float* gain, LAS float* scr, int gw, int NGW, int lane, bool f16) {
    const int nkb = K / 64, nnb = Ndst / 32, items = nkb * nnb;
    int it = gw; if (it >= items) return;
    int k0, n0, srcc0, nvalid; f32x4 cur[8], nxt[8];
    p0_item_map(it, nnb, Nsrc, maptype, k0, n0, srcc0, nvalid);
    p0_item_load(W, Nsrc, k0, srcc0, nvalid, lane, cur);
    for (;;) {
        const int itn = it + NGW; const bool more = itn < items; int k0n = 0, n0n = 0, srcn = 0, nvn = 0;
        if (more) { p0_item_map(itn, nnb, Nsrc, maptype, k0n, n0n, srcn, nvn); p0_item_load(W, Nsrc, k0n, srcn, nvn, lane, nxt); }
        p0_item_finish(cur, K, WT, n0, gain, scr, k0, lane, f16);
        if (!more) break;
#pragma unroll
        for (int i = 0; i < 8; ++i) cur[i] = nxt[i];
        it = itn; k0 = k0n; n0 = n0n;
    }
}

__device__ __forceinline__ void rows4_to_bf16_ss(const float* x, bf16* xb, float* ssp, _Float16* xh, int m0, int stride, int lane, int nrows) {
    f32x4 v[4][4];
#pragma unroll
    for (int r = 0; r < 4; ++r)
#pragma unroll
        for (int j = 0; j < 4; ++j) v[r][j] = (m0 + r * stride < nrows) ? ((const f32x4*)(x + (size_t)(m0 + r * stride) * DM))[64 * j + lane] : (f32x4){0.f, 0.f, 0.f, 0.f};
#pragma unroll
    for (int r = 0; r < 4; ++r) { if (m0 + r * stride >= nrows) continue; const size_t row = (size_t)(m0 + r * stride); float s = 0.f;
        unsigned long long* o8 = (unsigned long long*)(xb + row * DM) + lane;
#pragma unroll
        for (int j = 0; j < 4; ++j) { const f32x4 t = v[r][j]; s += (t.x * t.x + t.y * t.y) + (t.z * t.z + t.w * t.w);
            if (xb) o8[64 * j] = (unsigned long long)pk2(t.x, t.y) | ((unsigned long long)pk2(t.z, t.w) << 32);
            if (xh) ((pg8::f16x4*)(xh + row * DM))[64 * j + lane] = (pg8::f16x4){(_Float16)t.x, (_Float16)t.y, (_Float16)t.z, (_Float16)t.w}; }
        s = wave_sum(s);
        if (lane < 16) ssp[row * 16 + lane] = (lane == 0) ? s : 0.f; }
}

__device__ __forceinline__ void sincos_d(double a, float& c, float& s) {
    const double k = rint(a * 0.15915494309189535);
    const float r = (float)fma(-k, 6.283185307179586, a);
    const float r2 = r * r;
    float ps = 1.9572941e-20f;
    ps = fmaf(ps, r2, -8.2206352e-18f);
    ps = fmaf(ps, r2, 2.8114573e-15f);
    ps = fmaf(ps, r2, -7.6471637e-13f);
    ps = fmaf(ps, r2, 1.6059044e-10f);
    ps = fmaf(ps, r2, -2.5052108e-8f);
    ps = fmaf(ps, r2, 2.7557319e-6f);
    ps = fmaf(ps, r2, -1.9841270e-4f);
    ps = fmaf(ps, r2, 8.3333333e-3f);
    ps = fmaf(ps, r2, -1.6666667e-1f);
    ps = fmaf(ps, r2, 1.0f);
    float pc = -8.8967791e-22f;
    pc = fmaf(pc, r2, 4.1103176e-19f);
    pc = fmaf(pc, r2, -1.5619207e-16f);
    pc = fmaf(pc, r2, 4.7794773e-14f);
    pc = fmaf(pc, r2, -1.1470746e-11f);
    pc = fmaf(pc, r2, 2.0876757e-9f);
    pc = fmaf(pc, r2, -2.7557319e-7f);
    pc = fmaf(pc, r2, 2.4801587e-5f);
    pc = fmaf(pc, r2, -1.3888889e-3f);
    pc = fmaf(pc, r2, 4.1666667e-2f);
    pc = fmaf(pc, r2, -0.5f);
    pc = fmaf(pc, r2, 1.0f);
    s = ps * r; c = pc;
}

struct Ptrs {
    const float *x, *mem; const int* pos; const float *ln_g, *f1in, *f1out, *f2in, *f2out, *e_win, *e_fb, *e_qkg, *e_lam, *e_sub, *e_wout, *o_win, *o_conv, *o_qkg, *o_rel, *o_wout, *xwq, *xwkv, *xqkg, *xwo;
};

__device__ __forceinline__ void p0_prologue(const Ptrs& I, const Args& A, unsigned char* ws, LAS unsigned char* lds, int tid_in, float* xh_out) {
    int tid = tid_in; asm volatile("" : "+v"(tid));
    const int lane = tid & 63, wave = tid >> 6;
    LAS float* scr = (LAS float*)(lds + wave * 16384);
    const int gw = blockIdx.x * NWAVES + wave, NGW = gridDim.x * NWAVES;
#pragma unroll 1
    for (int id = 0; id < 9 * DEPTH; ++id) {
        const int l = id / 9, kind = id % 9, e = l >> 1; const bool ev = (l & 1) == 0;
        unsigned char* wl = ws + WS_W + (size_t)l * W_LAYER; const float* g = I.ln_g + (size_t)l * 5 * DM;
        const float* W; int K, Nsrc, Ndst, maptype; bf16* WT; const float* gain; bool f16;
        if (kind == 0)      { W = I.f1in + (size_t)l * DM * 2 * DFF; K = DM; Nsrc = 2 * DFF; WT = (bf16*)(wl + WO_1IN); Ndst = 2 * DFF; maptype = 1; gain = g + 0 * DM; f16 = true; }
        else if (kind == 1) { W = I.f1out + (size_t)l * DFF * DM; K = DFF; Nsrc = DM; WT = (bf16*)(wl + WO_1OUT); Ndst = DM; maptype = 0; gain = nullptr; f16 = false; }
        else if (kind == 2) { W = I.f2in + (size_t)l * DM * 2 * DFF; K = DM; Nsrc = 2 * DFF; WT = (bf16*)(wl + WO_2IN); Ndst = 2 * DFF; maptype = 1; gain = g + 4 * DM; f16 = true; }
        else if (kind == 3) { W = I.f2out + (size_t)l * DFF * DM; K = DFF; Nsrc = DM; WT = (bf16*)(wl + WO_2OUT); Ndst = DM; maptype = 0; gain = nullptr; f16 = false; }
        else if (kind == 4) { if (ev) { W = I.e_win + (size_t)e * DM * 3080; Nsrc = 3080; Ndst = 3328; maptype = 2; } else { W = I.o_win + (size_t)e * DM * 3072; Nsrc = 3072; Ndst = 3072; maptype = 0; }
                              K = DM; WT = (bf16*)(wl + WO_MIXIN); gain = g + 1 * DM; f16 = true; }
        else if (kind == 5) { W = (ev ? I.e_wout : I.o_wout) + (size_t)e * DM * DM; K = DM; Nsrc = DM; WT = (bf16*)(wl + WO_MIXOUT); Ndst = DM; maptype = 0; gain = nullptr; f16 = false; }
        else if (kind == 6) { W = I.xwq + (size_t)l * DM * DM; K = DM; Nsrc = DM; WT = (bf16*)(wl + WO_XQ); Ndst = DM; maptype = 0; gain = g + 2 * DM; f16 = true; }
        else if (kind == 7) { W = I.xwo + (size_t)l * DM * DM; K = DM; Nsrc = DM; WT = (bf16*)(wl + WO_XO); Ndst = DM; maptype = 0; gain = nullptr; f16 = false; }
        else                { W = I.xwkv + (size_t)l * DM * 2 * DM; K = DM; Nsrc = 2 * DM; WT = (bf16*)(ws + WS_WKV) + (size_t)l * 2048 * DM; Ndst = 2 * DM; maptype = 0; gain = g + 3 * DM; f16 = true; }
        p0_matrix(W, K, Nsrc, WT, Ndst, maptype, gain, scr, gw, NGW, lane, f16);
    }
    for (int m = gw; m < M; m += 4 * NGW) rows4_to_bf16_ss(I.x, nullptr, (float*)(ws + WS_SS), (_Float16*)xh_out, m, NGW, lane, M);
    for (int m = gw; m < MMEM; m += 4 * NGW) rows4_to_bf16_ss(I.mem, nullptr, (float*)(ws + WS_SSMEM), (_Float16*)(ws + WS_MEMB), m, NGW, lane, MMEM);
    float* cs = (float*)(ws + WS_CS);
    for (int it = blockIdx.x * NTHREADS + tid; it < M * 8; it += gridDim.x * NTHREADS) {
        const int m = it >> 3, i = it & 7; float c, s; sincos_d((double)I.pos[m] * A.inv[i], c, s);
        cs[(size_t)m * 16 + i] = c; cs[(size_t)m * 16 + 8 + i] = s;
        _Float16* csh = (_Float16*)(ws + WS_CSH); csh[(size_t)m * 16 + i] = (_Float16)c; csh[(size_t)m * 16 + 8 + i] = (_Float16)s;
    }
}

__device__ __forceinline__ float grp_sum(float v, int n) { for (int o = 1; o < n; o <<= 1) v += __shfl_xor(v, o); return v; }
__device__ __forceinline__ void kprep_phase(unsigned char* ws, int tid_in, int kind, const float* gains, const int*  ) {
    using namespace att;
    int tid = tid_in; asm volatile("" : "+v"(tid));
    const int lane = tid & 63, wave = tid >> 6;
    const int gw = blockIdx.x * NWAVES + wave, NGW = gridDim.x * NWAVES;
    if (kind == 2) {
        bf16* KX = (bf16*)(ws + WS_KX);
        float g0[8];
#pragma unroll
        for (int e = 0; e < 8; ++e) g0[e] = gains[256 + (lane & 31) * 8 + e];
        for (int m = gw; m < MMEM; m += 4 * NGW) {
            u32x4 ra[4], rb[4];
#pragma unroll
            for (int r = 0; r < 4; ++r) { const int row = m + r * NGW; const bool ok = row < MMEM; const bf16* rp = KX + (size_t)(ok ? row : 0) * DM + lane * 8;
                ra[r] = *(const u32x4*)rp; rb[r] = *(const u32x4*)(rp + 512); }
#pragma unroll
            for (int r = 0; r < 4; ++r) { const int row = m + r * NGW; if (row >= MMEM) continue; bf16* rp = KX + (size_t)row * DM + lane * 8;
                float x0[8], x1[8]; unpack8(ra[r], x0); unpack8(rb[r], x1); float s0 = 0.f, s1 = 0.f;
#pragma unroll
                for (int e = 0; e < 8; ++e) { s0 += x0[e] * x0[e]; s1 += x1[e] * x1[e]; }
                s0 = grp_sum(s0, 32); s1 = grp_sum(s1, 32);
                const float q0 = rsqrtf(s0 * (1.0f / 256.0f) + 1e-6f), q1 = rsqrtf(s1 * (1.0f / 256.0f) + 1e-6f);
#pragma unroll
                for (int e = 0; e < 8; ++e) { x0[e] *= q0 * g0[e]; x1[e] *= q1 * g0[e]; }
                *(u32x4*)rp = pack8(x0); *(u32x4*)(rp + 512) = pack8(x1); }
        }
    } else {
        bf16* P = (bf16*)(ws + WS_P);
        const _Float16* CSH = (const _Float16*)(ws + WS_CSH);
        const int pc = lane & 7, c0 = (kind == 0 ? 512 : 2048) + lane * 8;
        float ga[8], gb[8];
#pragma unroll
        for (int e = 0; e < 8; ++e) { ga[e] = gains[64 + pc * 8 + e]; gb[e] = (kind == 0) ? gains[192 + pc * 8 + e] : 0.f; }
        for (int m = gw; m < M; m += 4 * NGW) {
            u32x4 ra[4], rb[4], ca[4], cb[4];
#pragma unroll
            for (int r = 0; r < 4; ++r) { const int row = m + r * NGW; const bool ok = row < M; const bf16* rp = P + (size_t)(ok ? row : 0) * PP + c0;
                ra[r] = *(const u32x4*)rp;
                if (kind == 0) { rb[r] = *(const u32x4*)(rp + 1024); const u32x4* cp = (const u32x4*)(CSH + (size_t)(ok ? row : 0) * 16); ca[r] = cp[0]; cb[r] = cp[1]; } }
#pragma unroll
            for (int r = 0; r < 4; ++r) { const int row = m + r * NGW; if (row >= M) continue; bf16* rp = P + (size_t)row * PP + c0;
                float x0[8]; unpack8(ra[r], x0); float s0 = 0.f;
#pragma unroll
                for (int e = 0; e < 8; ++e) s0 += x0[e] * x0[e];
                s0 = grp_sum(s0, 8);
                const float q0 = rsqrtf(s0 * (1.0f / 64.0f) + 1e-6f);
#pragma unroll
                for (int e = 0; e < 8; ++e) x0[e] *= q0 * ga[e];
                if (kind == 0) {
                    const f16x8 ch = __builtin_bit_cast(f16x8, ca[r]), sh = __builtin_bit_cast(f16x8, cb[r]);
                    float x1[8]; unpack8(rb[r], x1); float s1 = 0.f;
#pragma unroll
                    for (int e = 0; e < 8; ++e) s1 += x1[e] * x1[e];
                    s1 = grp_sum(s1, 8);
                    const float q1 = rsqrtf(s1 * (1.0f / 64.0f) + 1e-6f);
#pragma unroll
                    for (int e = 0; e < 8; ++e) { x1[e] *= q1 * gb[e]; const float xp = __shfl_xor(x1[e], 1); const float c = (float)ch[e], sn = (float)sh[e];
                        const float rA = x1[e] * c - xp * sn, rB = x1[e] * c + xp * sn; x1[e] = (pc == 0) ? rA : ((pc == 1) ? rB : x1[e]); }
                    *(u32x4*)(rp + 1024) = pack8(x1);
                }
                *(u32x4*)rp = pack8(x0); }
        }
    }
}

__device__ __forceinline__ int vcu_index() { const int G = gridDim.x, bx = blockIdx.x; return (G % 8 == 0) ? (bx % 8) * (G / 8) + bx / 8 : bx; }
__device__ __forceinline__ float lds_absmax(const LAS float* p, int n, int lane) {
    float v = 0.f; for (int i = lane; i < n; i += 64) v = fmaxf(v, fabsf(p[i]));
#pragma unroll
    for (int o = 1; o < 64; o <<= 1) v = fmaxf(v, __shfl_xor(v, o));
    return v;
}

__device__ __forceinline__ float log_sigmoid(float z) { return (z >= 0.f) ? -log1pf(__expf(-z)) : (z - log1pf(__expf(z))); }

__device__ __forceinline__ void attn_even_phase(const Ptrs& I, unsigned char* ws, LAS unsigned char* lds, int tid_in, int layer, float* stash_base) {
    int tid = tid_in; asm volatile("" : "+v"(tid));
    using namespace att;
    const int lane = tid & 63, wave = __builtin_amdgcn_readfirstlane(tid >> 6), hi = lane >> 5, q31 = lane & 31, e = layer >> 1;
    const bf16* P = (const bf16*)(ws + WS_P); const bf16* VT = (const bf16*)(ws + WS_VT); bf16* OM = (bf16*)(ws + WS_OMIX);
    const float* CS = (const float*)(ws + WS_CS);
    const float* qkg_g = I.e_qkg + (size_t)e * 4 * 64;
    LAS float* qkg = (LAS float*)(lds + GOFF);
    const _Float16* CSH = (const _Float16*)(ws + WS_CSH);
    if (tid < 256) qkg[tid] = qkg_g[tid];
    __syncthreads();
    const bool bndA = 8.0f * att::LOG2E * lds_absmax(qkg, 64, lane) * lds_absmax(qkg + 64, 64, lane) < 60.0f;
    const bool bndB = 8.0f * att::LOG2E * lds_absmax(qkg + 128, 64, lane) * lds_absmax(qkg + 192, 64, lane) < 60.0f;
    for (int v = vcu_index(); v < 256; v += gridDim.x) {
        {
            const int b = v >> 3, h = v & 7;
            typedef Cfg<64, 2, 1> C0;
            LAS float* Fl = (LAS float*)(lds + C0::XOFF); LAS float* wsum = (LAS float*)(lds + C0::XOFF + 8192);
            {
                const float fb = I.e_fb[e * 8 + h]; float vv[4]; float run = 0.f;
#pragma unroll
                for (int j = 0; j < 4; ++j) { const int t = 4 * tid + j; const float af = bf2f_u(P[(size_t)(b * SEQ + t) * PP + 2048 + h]); run += log_sigmoid(af + fb); vv[j] = run; }
                float inc = run;
#pragma unroll
                for (int o = 1; o < 64; o <<= 1) { const float n = __shfl_up(inc, o); if (lane >= o) inc += n; }
                if (lane == 63) wsum[wave] = inc;
                __syncthreads();
                float base = inc - run;
                for (int w = 0; w < wave; ++w) base += wsum[w];
#pragma unroll
                for (int j = 0; j < 4; ++j) Fl[4 * tid + j] = (base + vv[j]) * LOG2E;
                __syncthreads();
            }
#pragma unroll 1
            for (int qb = 0; qb < 8; ++qb) {
                const int c = 4 * qb + (wave >> 1), qidx = 256 * qb + 32 * wave + q31; const size_t row = (size_t)b * SEQ + qidx;
                f32x16 O[2]; float l;
                attn_core<64, 2, 1, 0, 64>(lds, tid, P + row * PP + h * 64, qkg, qkg + 64, P + (size_t)b * SEQ * PP + 512 + h * 64, PP,
                                       VT + (size_t)(b * 512 + h * 64) * SEQ, SEQ, 0, 4 * qb + 4, 0, c, c, qidx, nullptr, nullptr, 0, bndA, O, l);
                store_o<2>(OM + row * DM + h * 64, O, 1.0f / l, hi);
            }
        }
        {
            asm volatile("" : "+v"(tid));
            const int pr = v >> 1, b = pr >> 2, h = pr & 3, odd = v & 1;
            const float lam_init = 0.8f - 0.6f * __expf(-0.3f * (float)layer);
            float lam;
            { const float* lp = I.e_lam + (size_t)e * 4 * 64; const float sa = wave_sum(lp[lane] * lp[64 + lane]), sb = wave_sum(lp[128 + lane] * lp[192 + lane]); lam = __expf(sa) - __expf(sb) + lam_init; }
            const float* sub = I.e_sub + (size_t)e * 128;
#pragma unroll 1
            for (int qi = 0; qi < 4; ++qi) {
                const int qb = odd ? ((qi == 0) ? 1 : (qi == 1) ? 2 : (qi == 2) ? 5 : 6) : ((qi == 0) ? 0 : (qi == 1) ? 3 : (qi == 2) ? 4 : 7);
                const int c = 4 * qb + (wave >> 1), qidx = 256 * qb + 32 * wave + q31; const size_t row = (size_t)b * SEQ + qidx;
                f32x16 O1[4]; float l1;
                float* stash = stash_base + (size_t)blockIdx.x * 32768 + tid * 64;
                {
                    attn_core<64, 4, 1, 1, 64>(lds, tid, P + row * PP + 1024 + h * 128, qkg + 128, qkg + 192, P + (size_t)b * SEQ * PP + 1536 + h * 128, PP,
                                           VT + (size_t)32 * 512 * SEQ + (size_t)(b * 512 + h * 128) * SEQ, SEQ, 0, 4 * qb + 4, 0, c, c, qidx, CS + row * 16, CSH + (size_t)b * SEQ * 16, 0, bndB, O1, l1);
                    const float i1 = 1.0f / l1;
#pragma unroll
                    for (int db = 0; db < 4; ++db)
#pragma unroll
                        for (int r4 = 0; r4 < 4; ++r4) *(f32x4*)(stash + db * 16 + 4 * r4) = (f32x4){O1[db][4 * r4] * i1, O1[db][4 * r4 + 1] * i1, O1[db][4 * r4 + 2] * i1, O1[db][4 * r4 + 3] * i1};
                }
                f32x16 O2[4]; float l2;
                attn_core<64, 4, 1, 1, 64>(lds, tid, P + row * PP + 1024 + h * 128 + 64, qkg + 128, qkg + 192, P + (size_t)b * SEQ * PP + 1536 + h * 128 + 64, PP,
                                       VT + (size_t)32 * 512 * SEQ + (size_t)(b * 512 + h * 128) * SEQ, SEQ, 0, 4 * qb + 4, 0, c, c, qidx, CS + row * 16, CSH + (size_t)b * SEQ * 16, 0, bndB, O2, l2);
                const float i2 = lam / l2; float ss = 0.f;
#pragma unroll
                for (int db = 0; db < 4; ++db)
#pragma unroll
                    for (int r4 = 0; r4 < 4; ++r4) { const f32x4 o1 = *(const f32x4*)(stash + db * 16 + 4 * r4);
#pragma unroll
                        for (int j = 0; j < 4; ++j) { const float d = o1[j] - i2 * O2[db][4 * r4 + j]; O2[db][4 * r4 + j] = d; ss += d * d; } }
                ss += __shfl_xor(ss, 32);
                const float rs = rsqrtf(ss * (1.0f / 128.0f) + 1e-6f) * (1.0f - lam_init);
#pragma unroll
                for (int db = 0; db < 4; ++db)
#pragma unroll
                    for (int a = 0; a < 2; ++a) { const float* gp = sub + 32 * db + 16 * a + 8 * hi;
#pragma unroll
                        for (int ee = 0; ee < 8; ++ee) O2[db][8 * a + ee] *= gp[ee]; }
                store_o<4>(OM + row * DM + 512 + h * 128, O2, rs, hi);
            }
        }
    }
}

__device__ __forceinline__ void attn_odd_phase(const Ptrs& I, unsigned char* ws, LAS unsigned char* lds, int tid_in, int layer) {
    int tid = tid_in; asm volatile("" : "+v"(tid));
    using namespace att;
    const int lane = tid & 63, wave = __builtin_amdgcn_readfirstlane(tid >> 6), hi = lane >> 5, q31 = lane & 31, o = layer >> 1;
    const bf16* P = (const bf16*)(ws + WS_P); const bf16* VT = (const bf16*)(ws + WS_VT); bf16* OM = (bf16*)(ws + WS_OMIX);
    const float* qkg_g = I.o_qkg + (size_t)o * 2 * 64;
    LAS float* qkg = (LAS float*)(lds + GOFF);
    if (tid < 128) qkg[tid] = qkg_g[tid];
    __syncthreads();
    for (int v = vcu_index(); v < 256; v += gridDim.x) {
        {
            const float* cw = I.o_conv + (size_t)o * 3 * 512 + lane * 8; float w0[8], w1[8], w2[8];
#pragma unroll
            for (int ee = 0; ee < 8; ++ee) { w0[ee] = cw[ee]; w1[ee] = cw[512 + ee]; w2[ee] = cw[1024 + ee]; }
            for (int rr = wave; rr < 256; rr += NWAVES) {
                const int row = 256 * v + rr, t = row & (SEQ - 1); const bf16* pr = P + (size_t)row * PP + lane * 8;
                float cb[8], u0[8], u1[8], u2[8], a[8], bb[8];
                unpack8(*(const u32x4*)(pr), cb);
                unpack8(*(const u32x4*)(pr + 512), a); unpack8(*(const u32x4*)(pr + 1024), bb);
#pragma unroll
                for (int ee = 0; ee < 8; ++ee) u2[ee] = a[ee] * bb[ee];
                if (t >= 1) { unpack8(*(const u32x4*)(pr - PP + 512), a); unpack8(*(const u32x4*)(pr - PP + 1024), bb);
#pragma unroll
                    for (int ee = 0; ee < 8; ++ee) u1[ee] = a[ee] * bb[ee]; }
                else {
#pragma unroll
                    for (int ee = 0; ee < 8; ++ee) u1[ee] = 0.f; }
                if (t >= 2) { unpack8(*(const u32x4*)(pr - 2 * PP + 512), a); unpack8(*(const u32x4*)(pr - 2 * PP + 1024), bb);
#pragma unroll
                    for (int ee = 0; ee < 8; ++ee) u0[ee] = a[ee] * bb[ee]; }
                else {
#pragma unroll
                    for (int ee = 0; ee < 8; ++ee) u0[ee] = 0.f; }
                float y[8];
#pragma unroll
                for (int ee = 0; ee < 8; ++ee) y[ee] = cb[ee] * (w0[ee] * u0[ee] + w1[ee] * u1[ee] + w2[ee] * u2[ee]);
                *(u32x4*)(OM + (size_t)row * DM + lane * 8) = pack8(y);
            }
        }
        {
            asm volatile("" : "+v"(tid));
            const int b = v >> 3, h = v & 7;
            typedef Cfg<64, 2, 1> C0;
            LAS float* tab = (LAS float*)(lds + C0::XOFF);
            __syncthreads();
            if (tid < 257) tab[tid] = I.o_rel[((size_t)o * 8 + h) * 257 + tid] * LOG2E;
            __syncthreads();
            const bool bnd = 8.0f * att::LOG2E * lds_absmax(qkg, 64, lane) * lds_absmax(qkg + 64, 64, lane) + lds_absmax(tab, 257, lane) < 60.0f;
#pragma unroll 1
            for (int qb = 0; qb < 8; ++qb) {
                const int c = 4 * qb + (wave >> 1), qidx = 256 * qb + 32 * wave + q31; const size_t row = (size_t)b * SEQ + qidx;
                const int kt0 = (4 * qb - 8) > 0 ? (4 * qb - 8) : 0, wlo = (c - 8) > 0 ? (c - 8) : 0;
                f32x16 O[2]; float l;
                attn_core<64, 2, 1, 2, 64>(lds, tid, P + row * PP + 1536 + h * 64, qkg, qkg + 64, P + (size_t)b * SEQ * PP + 2048 + h * 64, PP,
                                       VT + (size_t)(b * 512 + h * 64) * SEQ, SEQ, kt0, 4 * qb + 4, wlo, c, c, qidx, nullptr, nullptr, 0, bnd, O, l);
                store_o<2>(OM + row * DM + 512 + h * 64, O, 1.0f / l, hi);
            }
        }
    }
}

__device__ __forceinline__ void attn_cross_phase(const Ptrs& I, unsigned char* ws, LAS unsigned char* lds, int tid_in, int layer) {
    int tid = tid_in; asm volatile("" : "+v"(tid));
    using namespace att;
    const int lane = tid & 63, wave = __builtin_amdgcn_readfirstlane(tid >> 6), hi = lane >> 5, q31 = lane & 31;
    const bf16* QX = (const bf16*)(ws + WS_QX); const bf16* KX = (const bf16*)(ws + WS_KX); const bf16* VXT = (const bf16*)(ws + WS_VXT); bf16* OX = (bf16*)(ws + WS_OX);
    const float* qkg_g = I.xqkg + (size_t)layer * 2 * 256;
    LAS float* qkg = (LAS float*)(lds + GOFF);
    qkg[tid] = qkg_g[tid];
    __syncthreads();
    const bool bnd = 16.0f * att::LOG2E * lds_absmax(qkg, 256, lane) * lds_absmax(qkg + 256, 256, lane) < 60.0f;
    for (int v = vcu_index(); v < 256; v += gridDim.x) {
        const int pr = v >> 1, b = pr >> 2, h = pr & 3, ds = wave >> 2;
#pragma unroll 1
        for (int qi = 0; qi < 8; ++qi) {
            const int qblk = 8 * (v & 1) + qi, qidx = 128 * qblk + 32 * (wave & 3) + q31; const size_t row = (size_t)b * SEQ + qidx;
            f32x16 O[4]; float l;
            attn_core<256, 4, 2, 3, 32>(lds, tid, QX + row * DM + h * 256, qkg, qkg + 256, KX + (size_t)b * NMEM * DM + h * 256, DM,
                                    VXT + (size_t)(b * 1024 + h * 256) * NMEM, NMEM, 0, 8, 0, 7, 0, qidx, nullptr, nullptr, ds, bnd, O, l);
            store_o<4>(OX + row * DM + h * 256 + ds * 128, O, 1.0f / l, hi);
        }
    }
}

#define XB_TMO      128
#define XB_XCNT(j)  (256  + 64 * (j))
#define XB_XSUB(j)  (1280 + 64 * (j))
#define XB_XGEN(j)  (2304 + 64 * (j))
#define XB_TOP      3328
#define XB_TOPGEN   3392
#define XCD_BAR_WORDS 3456
#define XB_SPIN_CAP (1u << 18)

__device__ __forceinline__ unsigned xb_ld(unsigned* p)              { return __hip_atomic_load(p, __ATOMIC_RELAXED, __HIP_MEMORY_SCOPE_AGENT); }
__device__ __forceinline__ unsigned xb_add(unsigned* p, unsigned v) { return __hip_atomic_fetch_add(p, v, __ATOMIC_RELAXED, __HIP_MEMORY_SCOPE_AGENT); }
__device__ __forceinline__ unsigned xb_xcc_id() { return (unsigned)__builtin_amdgcn_s_getreg((3 << 11) | 20) & 0xFu; }
#define XB_SPIN(cond, bar) do { unsigned _sp = 0; while (cond) { __builtin_amdgcn_s_sleep(1); \
    if ((++_sp & 255u) == 0u) { if (xb_ld(&(bar)[XB_TMO])) break; if (_sp > XB_SPIN_CAP) { atomicAdd(&(bar)[XB_TMO], 1u); break; } } } } while (0)

struct XcdBarrier {
    unsigned* bar; unsigned x;
    volatile LAS unsigned* st;
};

__device__ __forceinline__ XcdBarrier xcd_barrier_post(unsigned* bar, volatile LAS unsigned* st) {
    XcdBarrier b; b.bar = bar; b.x = xb_xcc_id(); b.st = st;
    if (threadIdx.x == 0) (void)xb_add(&bar[XB_XCNT(b.x)], 1u);
    return b;
}
__device__ __forceinline__ void xcd_barrier_complete(unsigned* bar, unsigned x, unsigned& nloc, unsigned& nx) {
    const unsigned G = gridDim.x * gridDim.y * gridDim.z;
    unsigned sum, cnt, mine, sp = 0u;
    for (;;) {
        sum = 0u; cnt = 0u; mine = 0u;
#pragma unroll
        for (unsigned j = 0; j < 16; ++j) { const unsigned c = xb_ld(&bar[XB_XCNT(j)]); sum += c; cnt += (c > 0u) ? 1u : 0u; mine = (j == x) ? c : mine; }
        if (sum == G) break;
        __builtin_amdgcn_s_sleep(1);
        if ((++sp & 255u) == 0u) { if (xb_ld(&bar[XB_TMO])) break; if (sp > XB_SPIN_CAP) { atomicAdd(&bar[XB_TMO], 1u); break; } }
    }
    nloc = mine > 0u ? mine : 1u; nx = cnt > 0u ? cnt : 1u;
}

__device__ __forceinline__ void xcd_barrier(const XcdBarrier& b) {
    asm volatile("s_waitcnt vmcnt(0)" ::: "memory");
    __syncthreads();
    if (threadIdx.x == 0) {
        unsigned* bar = b.bar;
        __builtin_amdgcn_s_waitcnt(0);
        unsigned nloc = b.st[0], nx = b.st[1];
        if (nloc == 0u) { xcd_barrier_complete(bar, b.x, nloc, nx); b.st[0] = nloc; b.st[1] = nx; }
        const unsigned old = xb_add(&bar[XB_XSUB(b.x)], 1u);
        const unsigned gen = old / nloc;
        if (old + 1u == (gen + 1u) * nloc) {
            __builtin_amdgcn_fence(__ATOMIC_RELEASE, "agent");
            asm volatile("s_waitcnt vmcnt(0)" ::: "memory");
            const unsigned og = xb_add(&bar[XB_TOP], 1u);
            const unsigned tg = og / nx;
            if (og + 1u == (tg + 1u) * nx) xb_add(&bar[XB_TOPGEN], 1u);
            else XB_SPIN(xb_ld(&bar[XB_TOPGEN]) == tg, bar);
            __builtin_amdgcn_fence(__ATOMIC_ACQUIRE, "agent");
            xb_add(&bar[XB_XGEN(b.x)], 1u);
            asm volatile("s_waitcnt vmcnt(0)" ::: "memory");
        } else {
            XB_SPIN(xb_ld(&bar[XB_XGEN(b.x)]) == gen, bar);
            __builtin_amdgcn_fence(__ATOMIC_ACQUIRE, "agent");
            asm volatile("s_waitcnt vmcnt(0)" ::: "memory");
        }
    }
    __syncthreads();
}

#define GPTR0(T, v) ((T)(__attribute__((address_space(1))) unsigned char*)(v))
__global__ void __launch_bounds__(NTHREADS, 2) mega_fwd(Args A) {
    extern __shared__ __attribute__((aligned(16))) unsigned char smem[];
    LAS unsigned char* lds = (LAS unsigned char*)smem;
    volatile LAS unsigned* bar_st = (volatile LAS unsigned*)(lds + GOFF + 2048);
    if (threadIdx.x < 2) bar_st[threadIdx.x] = 0u;
    __syncthreads();
    XcdBarrier xbar = xcd_barrier_post((unsigned*)GPTR0(unsigned char*, (unsigned long long)A.ws), bar_st);
    for (int ph = A.ph_lo; ph < A.ph_hi; ++ph) {
        const int tid = threadIdx.x;
#define GPTR(T, v) ((T)(__attribute__((address_space(1))) unsigned char*)(v))
        unsigned long long wsi = (unsigned long long)A.ws; asm volatile("" : "+s"(wsi));
        unsigned char* ws = GPTR(unsigned char*, wsi);
        float* const outp = GPTR(float*, (unsigned long long)A.out);
        const __attribute__((address_space(4))) unsigned char* kp = (const __attribute__((address_space(4))) unsigned char*)__builtin_amdgcn_kernarg_segment_ptr();
        asm volatile("" : "+s"(kp));
#define INP(k) GPTR(const float*, ((const unsigned long long __attribute__((address_space(4)))*)kp)[k])
        Ptrs I;
        I.x = INP(0); I.mem = INP(1); I.pos = (const int*)INP(2); I.ln_g = INP(3); I.f1in = INP(4); I.f1out = INP(5); I.f2in = INP(6); I.f2out = INP(7);
        I.e_win = INP(8); I.e_fb = INP(9); I.e_qkg = INP(10); I.e_lam = INP(11); I.e_sub = INP(12); I.e_wout = INP(13);
        I.o_win = INP(14); I.o_conv = INP(15); I.o_qkg = INP(16); I.o_rel = INP(17); I.o_wout = INP(18);
        I.xwq = INP(19); I.xwkv = INP(20); I.xqkg = INP(21); I.xwo = INP(22);
#undef INP
        float* SSb = (float*)(ws + WS_SS);
        const bf16* XB = nullptr;
        if (ph == 0) {
#ifndef NO_P0
            p0_prologue(I, A, ws, lds, tid, outp);
#endif
        } else {
            const int l = (ph - 1) / 12, kq = (ph - 1) % 12; const bool even = (l & 1) == 0;
            const int k = (kq <= 2) ? kq : (kq == 3) ? 100 : (kq <= 6) ? kq - 1 : (kq == 7) ? 101 : kq - 2;
            unsigned char* wl = ws + WS_W + (size_t)l * W_LAYER;
            XB = (l == DEPTH - 1 && k == 8) ? (const bf16*)(ws + WS_OMIX) : (const bf16*)outp;
            if (k == 0 || k == 8) {
                pg8::Gemm g{XB, (const bf16*)(wl + (k == 0 ? WO_1IN : WO_2IN)), M, 2 * DFF, DM};
                pg8::StaticOrder S; S.init(M, 2 * DFF, (int)gridDim.x, (int)blockIdx.x);
                pg8::EpiSwiglu E{(bf16*)(ws + WS_H), SSb, {{0.f, 0.f, 0.f, 0.f}, {0.f, 0.f, 0.f, 0.f}}, -1};
#ifndef NO_SWIGLU
                pg8::gemm_phase<pg8::EpiSwiglu, pg8::StaticOrder, true, true, true>(lds, g, S, E);
#endif
            } else if (k == 1 || k == 4 || k == 7 || k == 9) {
                const bf16* Aop = (k == 1 || k == 9) ? (const bf16*)(ws + WS_H) : (k == 4) ? (const bf16*)(ws + WS_OMIX) : (const bf16*)(ws + WS_OX);
                const bf16* Bop = (const bf16*)(wl + (k == 1 ? WO_1OUT : k == 9 ? WO_2OUT : k == 4 ? WO_MIXOUT : WO_XO));
                const int Kd = (k == 1 || k == 9) ? DFF : DM;
                pg8::Gemm g{Aop, Bop, M, DM, Kd};
                pg8::StaticOrder S; S.init(M, DM, (int)gridDim.x, (int)blockIdx.x);
                const bool fin = (l == DEPTH - 1 && k == 9), pre = (l == DEPTH - 1 && k == 7);
                pg8::EpiResid E{fin ? (const _Float16*)(ws + WS_OMIX) : (const _Float16*)outp, pre ? (_Float16*)(ws + WS_OMIX) : (_Float16*)outp, nullptr, SSb, A.zero_alpha ? 0.0f : ((k == 1 || k == 9) ? 0.5f : 1.0f), fin ? outp : nullptr};
#ifndef NO_RESID
                pg8::gemm_phase<pg8::EpiResid, pg8::StaticOrder, true, true>(lds, g, S, E);
#endif
            } else if (k == 2 || k == 5) {
                const int nrep = (k == 5) ? 2 : 1;
                for (int rep = 0; rep < nrep; ++rep) {
                    pg8::Gemm g; pg8::EpiProj E; int Md, Nd;
                    if (k == 2) { Md = M; Nd = even ? 3328 : 3072; g = pg8::Gemm{XB, (const bf16*)(wl + WO_MIXIN), Md, Nd, DM};
                        E = pg8::EpiProj{(bf16*)(ws + WS_P), PP, SSb, even ? 9 : 10, (bf16*)(ws + WS_VT), 11, 9, {{0.f, 0.f, 0.f, 0.f}, {0.f, 0.f, 0.f, 0.f}}, -1}; }
                    else if (rep == 0) { Md = M; Nd = DM; g = pg8::Gemm{XB, (const bf16*)(wl + WO_XQ), Md, Nd, DM};
                        E = pg8::EpiProj{(bf16*)(ws + WS_QX), DM, SSb, 4, nullptr, 11, 9, {{0.f, 0.f, 0.f, 0.f}, {0.f, 0.f, 0.f, 0.f}}, -1}; }
                    else { Md = MMEM; Nd = 2 * DM; g = pg8::Gemm{(const bf16*)(ws + WS_MEMB), (const bf16*)(ws + WS_WKV) + (size_t)l * 2048 * DM, Md, Nd, DM};
                        E = pg8::EpiProj{(bf16*)(ws + WS_KX), DM, (const float*)(ws + WS_SSMEM), 4, (bf16*)(ws + WS_VXT), 8, 10, {{0.f, 0.f, 0.f, 0.f}, {0.f, 0.f, 0.f, 0.f}}, -1}; }
                    pg8::StaticOrder S; S.init(Md, Nd, (int)gridDim.x, (int)blockIdx.x);
#ifndef NO_PROJ
                    pg8::gemm_phase<pg8::EpiProj, pg8::StaticOrder, true, true, true>(lds, g, S, E);
#endif
                    __syncthreads();
                }
            } else if (k == 100) {
                kprep_phase(ws, tid, even ? 0 : 1, even ? I.e_qkg + (size_t)(l >> 1) * 256 : I.o_qkg + (size_t)(l >> 1) * 128, nullptr);
            } else if (k == 101) {
                kprep_phase(ws, tid, 2, I.xqkg + (size_t)l * 512, nullptr);
            } else if (k == 3) {
                #ifndef NO_EVEN
                if (even) attn_even_phase(I, ws, lds, tid, l, outp + (size_t)32 * MiB);
#endif
#ifndef NO_ODD
                if (!even) attn_odd_phase(I, ws, lds, tid, l);
#endif
            } else {
#ifndef NO_CROSS
                attn_cross_phase(I, ws, lds, tid, l);
#endif
            }
        }
        if (ph + 1 < A.ph_hi) { if (ph == 0) cg::this_grid().sync(); else xcd_barrier(xbar); }
    }
}

extern "C" void kernel_launch(void* const* d_in, const int* in_sizes, int n_in, void* d_out, int out_size, void* d_ws, size_t ws_size, hipStream_t stream) {
    static int grid = 0;
    if (grid == 0) {
        if (n_in != 23 || out_size != M * DM || ws_size < WS_END) { fprintf(stderr, "kernel_launch: unexpected shapes (n_in %d out %d ws %zu)\n", n_in, out_size, ws_size); grid = -1; return; }
        int dev = 0, cus = 0, per_cu = 0;
        hipGetDevice(&dev); hipDeviceGetAttribute(&cus, hipDeviceAttributeMultiprocessorCount, dev);
        if (hipFuncSetAttribute((const void*)mega_fwd, hipFuncAttributeMaxDynamicSharedMemorySize, LDS_BYTES) != hipSuccess) { fprintf(stderr, "kernel_launch: hipFuncSetAttribute failed\n"); grid = -1; return; }
        if (hipOccupancyMaxActiveBlocksPerMultiprocessor(&per_cu, (const void*)mega_fwd, NTHREADS, LDS_BYTES) != hipSuccess || per_cu < 1) { fprintf(stderr, "kernel_launch: occupancy query says %d\n", per_cu); per_cu = 1; }
        (void)hipGetLastError();
        grid = cus * per_cu; if (grid > 256) grid = 256;
        fprintf(stderr, "kernel_launch: grid %d (cus %d x %d)\n", grid, cus, per_cu);
    }
    if (grid < 0) return;
    (void)hipMemsetAsync(d_ws, 0, 16384, stream);
    Args a{};
    for (int i = 0; i < 23; ++i) a.in[i] = (const float*)d_in[i];
    a.out = (float*)d_out; a.ws = (unsigned char*)d_ws;
    for (int i = 0; i < 8; ++i) a.inv[i] = std::pow(500000.0, -(double)i / 8.0);
    const int NPH = 1 + 12 * DEPTH;
#if MK_SINGLE
    a.ph_lo = 0; a.ph_hi = NPH;
    void* args[] = {&a};
    hipError_t e = hipLaunchCooperativeKernel((const void*)mega_fwd, dim3(grid), dim3(NTHREADS), args, LDS_BYTES, stream);
    if (e != hipSuccess) fprintf(stderr, "cooperative launch failed: %s (grid %d)\n", hipGetErrorString(e), grid);
#else
#ifndef REP_MASK
#define REP_MASK 0
#endif
    for (int ph = 0; ph < NPH; ++ph) { a.ph_lo = ph; a.ph_hi = ph + 1;
        const int kq_ = (ph == 0) ? -1 : (ph - 1) % 12; const int kk = (kq_ < 0) ? -1 : (kq_ <= 2) ? kq_ : (kq_ == 3) ? 100 : (kq_ <= 6) ? kq_ - 1 : (kq_ == 7) ? 101 : kq_ - 2; int nrun = 1;
        if (((REP_MASK & 1) && (kk == 0 || kk == 8)) || ((REP_MASK & 2) && kk == 2) || ((REP_MASK & 4) && kk == 3) || ((REP_MASK & 8) && kk == 5) || ((REP_MASK & 16) && kk == 6) || ((REP_MASK & 32) && ph == 0) || ((REP_MASK & 512) && (kk == 100 || kk == 101)) || ((REP_MASK & 64) && kk == 3 && (((ph - 1) / 12) & 1) == 0) || ((REP_MASK & 128) && kk == 3 && (((ph - 1) / 12) & 1) == 1)) nrun = 2;
        if ((REP_MASK & 256) && (kk == 1 || kk == 4 || kk == 7 || kk == 9)) { a.zero_alpha = 1; hipLaunchKernelGGL(mega_fwd, dim3(grid), dim3(NTHREADS), LDS_BYTES, stream, a); a.zero_alpha = 0; }
        for (int r = 0; r < nrun; ++r) hipLaunchKernelGGL(mega_fwd, dim3(grid), dim3(NTHREADS), LDS_BYTES, stream, a); }
#endif
}
```

```cpp
#include <hip/hip_runtime.h>
#include <hip/hip_cooperative_groups.h>
#include <cstdio>
#include <cstdint>
#include <cmath>
#define MK_SINGLE 1
namespace pg8 {
#define PG8_LAS __attribute__((address_space(3)))
typedef unsigned short bf16_t;
typedef short bf16x8 __attribute__((ext_vector_type(8)));
typedef float f32x4 __attribute__((ext_vector_type(4)));
typedef unsigned u32x4 __attribute__((ext_vector_type(4)));
constexpr int BM = 256, BK = 64, HALF = 128, HTB = HALF * BK * 2  , STAGE_BYTES = 8 * HTB, NXCD = 8, WGM = 8;

__host__ __device__ __forceinline__ int lds_byte(int r, int c) { const int st = (r >> 4) * 2 + (c >> 5), rr = r & 15, cc = c & 31, ob = rr * 64 + cc * 2; return st * 1024 + (ob ^ (((ob >> 9) & 1) << 5)); }
__host__ __device__ __forceinline__ void stage_rc(int b, int& R, int& C) { const int st = b / 1024, sb = b % 1024, swz = sb ^ (((sb >> 9) & 1) << 5); R = (st >> 1) * 16 + swz / 64; C = (st & 1) * 32 + (swz % 64) / 2; }
__host__ __device__ __forceinline__ int perm32(int rho) { const int n = rho >> 4, i = rho & 15; return 8 * (i >> 2) + 4 * n + (i & 3); }

struct Unit { int pm, pn; };
struct Gemm { const bf16_t* A; const bf16_t* Bt; int M, N, K; };

struct StaticOrder {
    int nM, nN, nwg, G, c;
    __host__ __device__ void init(int M, int N, int G_, int c_) { nM = M / BM; nN = N / BM; nwg = nM * nN; G = G_; c = c_; }
    __host__ __device__ bool next(int i, Unit& u) const {
        const long L = (long)i * G + c; if (L >= nwg) return false;
        int wgid = (int)L; { const int q = nwg / NXCD, r = nwg % NXCD, xcd = wgid % NXCD, off = wgid / NXCD; wgid = (xcd < r ? xcd * (q + 1) : r * (q + 1) + (xcd - r) * q) + off; }
        const int nig = WGM * nN, gid = wgid / nig, fm = gid * WGM, gsz = (nM - fm) < WGM ? (nM - fm) : WGM;
        u.pm = fm + ((wgid % nig) % gsz); u.pn = (wgid % nig) / gsz; return true;
    }
    __device__ __forceinline__ void a_ready(const Unit&) const {}
    __device__ __forceinline__ void done(const Unit&) const {}
};

__device__ __forceinline__ unsigned cvt_pk_bf16(float lo, float hi) { unsigned r; asm volatile("v_cvt_pk_bf16_f32 %0, %1, %2" : "=v"(r) : "v"(lo), "v"(hi)); return r; }
typedef float f32x2 __attribute__((ext_vector_type(2)));

typedef unsigned u32x2 __attribute__((ext_vector_type(2)));
typedef _Float16 f16x8v __attribute__((ext_vector_type(8)));
__device__ __forceinline__ float bf2f(unsigned v) { return __uint_as_float(v << 16); }
__device__ __forceinline__ float row_rs(const float* SSP, int row) {
    const f32x4* p = (const f32x4*)(SSP + (size_t)row * 16); const f32x4 a = p[0], b = p[1], c = p[2], d = p[3];
    const float s = (((a[0] + a[1]) + (a[2] + a[3])) + ((b[0] + b[1]) + (b[2] + b[3]))) + (((c[0] + c[1]) + (c[2] + c[3])) + ((d[0] + d[1]) + (d[2] + d[3])));
    return rsqrtf(s * (1.0f / 1024.0f) + 1e-6f);
}

struct EpiSwiglu {
    static constexpr bool PERM = true, AFTER_DRAIN = false;
    bf16_t* H; const float* SS;
    mutable float rsv[2][4]; mutable int last_pm;
    __device__ __forceinline__ void operator()(const f32x4 (&acc)[2][2][4][2], const Unit& u, int wr, int wc, int fr, int fq) const {
        const int row0 = u.pm * BM + wr * 64 + fr; const int col0 = u.pn * 128 + wc * 32 + 8 * fq;
        if (u.pm != last_pm) {
            last_pm = u.pm;
#pragma unroll
            for (int ai = 0; ai < 2; ++ai)
#pragma unroll
                for (int m = 0; m < 4; ++m) rsv[ai][m] = row_rs(SS, row0 + ai * HALF + m * 16);
        }
#pragma unroll
        for (int ai = 0; ai < 2; ++ai)
#pragma unroll
            for (int m = 0; m < 4; ++m) {
                const int row = row0 + ai * HALF + m * 16;
                const float rs = rsv[ai][m];
                unsigned w[4];
#pragma unroll
                for (int n = 0; n < 2; ++n) {
                    const f32x4 g = acc[ai][0][m][n] * rs, uu = acc[ai][1][m][n] * rs; float hv[4];
#pragma unroll
                    for (int j = 0; j < 4; ++j) { const float e = __expf(-g[j]); hv[j] = g[j] * __builtin_amdgcn_rcpf(1.0f + e) * uu[j]; }
                    w[2 * n] = cvt_pk_bf16(hv[0], hv[1]); w[2 * n + 1] = cvt_pk_bf16(hv[2], hv[3]);
                }
                *(u32x4*)(H + (size_t)row * 2816 + col0) = (u32x4){w[0], w[1], w[2], w[3]};
            }
    }
};

typedef _Float16 f16x4 __attribute__((ext_vector_type(4)));
typedef _Float16 f16x8 __attribute__((ext_vector_type(8)));
struct EpiResid {
    static constexpr bool PERM = true, AFTER_DRAIN = false;
    const _Float16* xin; _Float16* xout; bf16_t* XB; float* SSn; float alpha; float* outf;
    __device__ __forceinline__ void operator()(const f32x4 (&acc)[2][2][4][2], const Unit& u, int wr, int wc, int fr, int fq) const {
        const int row0 = u.pm * BM + wr * 64 + fr; const int col0 = u.pn * BM + wc * 32 + 8 * fq;
        f16x8 xhv[2][4][2];
#pragma unroll
        for (int ai = 0; ai < 2; ++ai)
#pragma unroll
            for (int m = 0; m < 4; ++m)
#pragma unroll
                for (int bj = 0; bj < 2; ++bj) xhv[ai][m][bj] = *(const f16x8*)(xin + (size_t)(row0 + ai * HALF + m * 16) * 1024 + col0 + bj * HALF);
#pragma unroll
        for (int ai = 0; ai < 2; ++ai) {
#pragma unroll
            for (int m = 0; m < 4; ++m) {
                const int row = row0 + ai * HALF + m * 16; const size_t off = (size_t)row * 1024 + col0; float ss = 0.f;
#pragma unroll
                for (int bj = 0; bj < 2; ++bj) {
                    const size_t o = off + bj * HALF;
                    const f16x8 xh = xhv[ai][m][bj];
                    const f32x4 x0 = (f32x4){(float)xh[0], (float)xh[1], (float)xh[2], (float)xh[3]} + acc[ai][bj][m][0] * alpha;
                    const f32x4 x1 = (f32x4){(float)xh[4], (float)xh[5], (float)xh[6], (float)xh[7]} + acc[ai][bj][m][1] * alpha;
                    if (outf) { *(f32x4*)(outf + o) = x0; *(f32x4*)(outf + o + 4) = x1; }
                    else {
                        *(f16x8*)(xout + o) = (f16x8){(_Float16)x0[0], (_Float16)x0[1], (_Float16)x0[2], (_Float16)x0[3], (_Float16)x1[0], (_Float16)x1[1], (_Float16)x1[2], (_Float16)x1[3]};
                        ss += ((x0[0] * x0[0] + x0[1] * x0[1]) + (x0[2] * x0[2] + x0[3] * x0[3])) + ((x1[0] * x1[0] + x1[1] * x1[1]) + (x1[2] * x1[2] + x1[3] * x1[3]));
                    }
                }
                if (!outf) { ss += __shfl_xor(ss, 16); ss += __shfl_xor(ss, 32);
                    if (fq == 0) SSn[(size_t)row * 16 + u.pn * 4 + wc] = ss; }
            }
        }
    }
};

struct EpiProj {
    static constexpr bool PERM = true, AFTER_DRAIN = false;
    bf16_t* P; int ldp; const float* SS; int nP; bf16_t* VT; int tsh; int cwsh;
    mutable float rsv[2][4]; mutable int last_pm;
    __device__ __forceinline__ void operator()(const f32x4 (&acc)[2][2][4][2], const Unit& u, int wr, int wc, int fr, int fq) const {
        const int row0 = u.pm * BM + wr * 64 + fr;
        if (u.pm != last_pm) {
            last_pm = u.pm;
#pragma unroll
            for (int ai = 0; ai < 2; ++ai)
#pragma unroll
                for (int m = 0; m < 4; ++m) rsv[ai][m] = row_rs(SS, row0 + ai * HALF + m * 16);
        }
        if (u.pn < nP) {
            const int col0 = u.pn * BM + wc * 32 + 8 * fq;
#pragma unroll
            for (int ai = 0; ai < 2; ++ai)
#pragma unroll
                for (int m = 0; m < 4; ++m) {
                    const int row = row0 + ai * HALF + m * 16;
                    const float rs = rsv[ai][m];
                    bf16_t* rowp = P + (size_t)row * ldp + col0;
#pragma unroll
                    for (int bj = 0; bj < 2; ++bj) {
                        const f32x4 v0 = acc[ai][bj][m][0] * rs, v1 = acc[ai][bj][m][1] * rs;
                        u32x4 w; w.x = cvt_pk_bf16(v0[0], v0[1]); w.y = cvt_pk_bf16(v0[2], v0[3]); w.z = cvt_pk_bf16(v1[0], v1[1]); w.w = cvt_pk_bf16(v1[2], v1[3]);
                        *(u32x4*)(rowp + bj * HALF) = w;
                    }
                }
        } else {
            const int T = 1 << tsh, CWm = (1 << cwsh) - 1;
            const int ccb = (u.pn - nP) * BM + wc * 32 + 8 * fq;
#pragma unroll
            for (int ai = 0; ai < 2; ++ai)
#pragma unroll
                for (int m = 0; m < 4; ++m) {
                    const int row = row0 + ai * HALF + m * 16;
                    const float rs = rsv[ai][m];
                    const int b = row >> tsh, t = row & (T - 1);
                    const int odd = fr & 1, te = t & ~1;
#pragma unroll
                    for (int bj = 0; bj < 2; ++bj)
#pragma unroll
                        for (int n = 0; n < 2; ++n)
#pragma unroll
                            for (int jp = 0; jp < 2; ++jp) {
                                const float va = acc[ai][bj][m][n][2 * jp] * rs, vb = acc[ai][bj][m][n][2 * jp + 1] * rs;
                                const float give = odd ? va : vb;
                                const float got = __builtin_bit_cast(float, __builtin_amdgcn_update_dpp(0, __builtin_bit_cast(int, give), 0xB1, 0xF, 0xF, true));
                                const int j = 2 * jp + odd;
                                const unsigned w = odd ? cvt_pk_bf16(got, vb) : cvt_pk_bf16(va, got);
                                const int cc = ccb + bj * HALF + 4 * n + j;
                                const size_t o = ((size_t)((((cc >> cwsh) * 32 + b) << cwsh) + (cc & CWm)) << tsh) + te;
                                *(unsigned*)(VT + o) = w;
                            }
                }
        }
    }
};
template <class Epi, class Sched, bool ALIGN_EPI = false, bool SP2 = false, bool F16 = false>
__device__ __forceinline__ void gemm_phase(PG8_LAS unsigned char* lds, const Gemm g, const Sched& S, const Epi& E) {
    int tid_raw_ = threadIdx.x; asm volatile("" : "+v"(tid_raw_));
    const int tid = tid_raw_, wid = __builtin_amdgcn_readfirstlane(tid >> 6), lane = tid & 63, wr = wid >> 2, wc = wid & 3, fr = lane & 15, fq = lane >> 4;
    const int K = g.K, nt = K / BK;
    unsigned voffA[2], voffB[2];
#pragma unroll
    for (int i = 0; i < 2; ++i) { int R, C; stage_rc(tid * 16 + i * 8192, R, C); const int Rb = Epi::PERM ? ((R & ~31) + perm32(R & 31)) : R;
        voffA[i] = (unsigned)(R * K + C) * 2u; voffB[i] = (unsigned)(Rb * K + C) * 2u; }
    const size_t kstep = (size_t)(BK * 2);
    const size_t hstep = (size_t)HALF * K * 2;
    const size_t tstep = 2 * hstep;
    const unsigned ldsw = (unsigned)wid * 1024u;
    const int aoff = lds_byte(wr * 64 + fr, fq * 8), boff = lds_byte(wc * 32 + fr, fq * 8);
#define PG8_SA(b, h) (((b) * 2 + (h)) * HTB)
#define PG8_SB(b, h) ((4 + (b) * 2 + (h)) * HTB)
#define PG8_STAGE(bufoff, gbase, voff) do { _Pragma("unroll") for (int _i = 0; _i < 2; ++_i) \
        __builtin_amdgcn_global_load_lds((const unsigned*)((const char*)(gbase) + (voff)[_i]), (PG8_LAS unsigned*)(lds + (bufoff) + ldsw + _i * 8192), 16, 0, 0); } while (0)
#define PG8_LDA(dst, b, h) do { _Pragma("unroll") for (int m = 0; m < 4; ++m) _Pragma("unroll") for (int k = 0; k < 2; ++k) dst[m][k] = *(const PG8_LAS bf16x8*)(lds + PG8_SA(b, h) + aoff + m * 2048 + k * 1024); } while (0)
#define PG8_LDB(dst, b, h) do { _Pragma("unroll") for (int n = 0; n < 2; ++n) _Pragma("unroll") for (int k = 0; k < 2; ++k) dst[n][k] = *(const PG8_LAS bf16x8*)(lds + PG8_SB(b, h) + boff + n * 2048 + k * 1024); } while (0)
#define PG8_MMA(ai, bj, At, Bt) do { __builtin_amdgcn_s_setprio(1); _Pragma("unroll") for (int m = 0; m < 4; ++m) _Pragma("unroll") for (int n = 0; n < 2; ++n) _Pragma("unroll") for (int k = 0; k < 2; ++k) \
        acc[ai][bj][m][n] = F16 ? __builtin_amdgcn_mfma_f32_16x16x32_f16(__builtin_bit_cast(f16x8v, Bt[n][k]), __builtin_bit_cast(f16x8v, At[m][k]), acc[ai][bj][m][n], 0, 0, 0) : __builtin_amdgcn_mfma_f32_16x16x32_bf16(Bt[n][k], At[m][k], acc[ai][bj][m][n], 0, 0, 0); __builtin_amdgcn_s_setprio(0); } while (0)
#define PG8_WAIT_V(n) asm volatile("s_waitcnt vmcnt(" #n ")" ::: "memory")
#define PG8_WAIT_L(n) asm volatile("s_waitcnt lgkmcnt(" #n ")" ::: "memory")
#define PG8_BAR __builtin_amdgcn_s_barrier()
#define PG8_SCHED __builtin_amdgcn_sched_barrier(0)
    Unit cur, nxt; int ui = 0;
    if (!S.next(0, cur)) return;
    f32x4 acc[2][2][4][2];
#pragma unroll
    for (int a = 0; a < 2; ++a)
#pragma unroll
        for (int b = 0; b < 2; ++b)
#pragma unroll
            for (int m = 0; m < 4; ++m)
#pragma unroll
                for (int n = 0; n < 2; ++n) acc[a][b][m][n] = (f32x4){0.f, 0.f, 0.f, 0.f};
    bf16x8 At[4][2], B0[2][2], B1[2][2];
    const char* cA = (const char*)g.A + (size_t)cur.pm * tstep; const char* cB = (const char*)g.Bt + (size_t)cur.pn * tstep;
    S.a_ready(cur);
    if constexpr (SP2) {
        PG8_STAGE(PG8_SB(0, 0), cB, voffB); PG8_STAGE(PG8_SB(0, 1), cB + hstep, voffB); PG8_STAGE(PG8_SA(0, 0), cA, voffA); PG8_STAGE(PG8_SA(0, 1), cA + hstep, voffA);
        if (wr == 1) PG8_BAR;
        PG8_WAIT_V(2); PG8_BAR;
        PG8_STAGE(PG8_SB(1, 0), cB + kstep, voffB); PG8_STAGE(PG8_SA(1, 0), cA + kstep, voffA); PG8_STAGE(PG8_SB(1, 1), cB + hstep + kstep, voffB);
        PG8_WAIT_V(6); PG8_BAR;
    } else {
        PG8_STAGE(PG8_SB(0, 0), cB, voffB); PG8_STAGE(PG8_SA(0, 0), cA, voffA); PG8_STAGE(PG8_SB(0, 1), cB + hstep, voffB); PG8_STAGE(PG8_SA(0, 1), cA + hstep, voffA);
        if (wr == 1) PG8_BAR;
        PG8_WAIT_V(4); PG8_BAR;
        PG8_STAGE(PG8_SB(1, 0), cB + kstep, voffB); PG8_STAGE(PG8_SA(1, 0), cA + kstep, voffA); PG8_STAGE(PG8_SB(1, 1), cB + hstep + kstep, voffB);
        PG8_WAIT_V(6); PG8_BAR;
    }
    for (;;) {
        const bool has_next = S.next(ui + 1, nxt);
        const char* nA = has_next ? (const char*)g.A + (size_t)nxt.pm * tstep : cA; const char* nB = has_next ? (const char*)g.Bt + (size_t)nxt.pn * tstep : cB;
        for (int t = 0; t < nt; t += 2) {
            const bool last = (t == nt - 2);
            const char* a1 = cA + (size_t)(t + 1) * kstep;
            const char* a2 = last ? nA : cA + (size_t)(t + 2) * kstep; const char* b2 = last ? nB : cB + (size_t)(t + 2) * kstep;
            const char* a3 = a2 + kstep; const char* b3 = b2 + kstep;
            if (last && has_next) S.a_ready(nxt);
            if constexpr (SP2) {
            PG8_LDB(B0, 0, 0); PG8_LDB(B1, 0, 1); PG8_SCHED; PG8_LDA(At, 0, 0); PG8_STAGE(PG8_SA(1, 1), a1 + hstep, voffA);
            PG8_WAIT_V(8); PG8_WAIT_L(0); PG8_BAR; PG8_MMA(0, 0, At, B0); PG8_MMA(0, 1, At, B1); PG8_BAR; PG8_SCHED;
            PG8_LDA(At, 0, 1); PG8_STAGE(PG8_SB(0, 0), b2, voffB); PG8_STAGE(PG8_SB(0, 1), b2 + hstep, voffB); PG8_STAGE(PG8_SA(0, 0), a2, voffA);
            PG8_WAIT_V(8); PG8_WAIT_L(0); PG8_BAR; PG8_MMA(1, 0, At, B0); PG8_MMA(1, 1, At, B1); PG8_BAR; PG8_SCHED;
            PG8_LDB(B0, 1, 0); PG8_LDB(B1, 1, 1); PG8_SCHED; PG8_LDA(At, 1, 0); PG8_STAGE(PG8_SA(0, 1), a2 + hstep, voffA);
            PG8_WAIT_V(8); PG8_WAIT_L(0); PG8_BAR; PG8_MMA(0, 0, At, B0); PG8_MMA(0, 1, At, B1); PG8_BAR; PG8_SCHED;
            PG8_LDA(At, 1, 1); PG8_STAGE(PG8_SB(1, 0), b3, voffB); PG8_STAGE(PG8_SB(1, 1), b3 + hstep, voffB); PG8_STAGE(PG8_SA(1, 0), a3, voffA);
            PG8_WAIT_V(8); PG8_WAIT_L(0); PG8_BAR; PG8_MMA(1, 0, At, B0); PG8_MMA(1, 1, At, B1); PG8_BAR; PG8_SCHED;
            } else {
            PG8_LDB(B0, 0, 0); PG8_SCHED; PG8_LDA(At, 0, 0); PG8_STAGE(PG8_SA(1, 1), a1 + hstep, voffA);
            PG8_WAIT_L(8); PG8_BAR; PG8_WAIT_L(0); PG8_MMA(0, 0, At, B0); PG8_BAR; PG8_SCHED;
            PG8_LDB(B1, 0, 1); PG8_STAGE(PG8_SB(0, 0), b2, voffB);
            PG8_BAR; PG8_WAIT_L(0); PG8_MMA(0, 1, At, B1); PG8_BAR;
            PG8_LDA(At, 0, 1); PG8_STAGE(PG8_SA(0, 0), a2, voffA);
            PG8_BAR; PG8_WAIT_L(0); PG8_MMA(1, 0, At, B0); PG8_BAR; PG8_SCHED;
            PG8_STAGE(PG8_SB(0, 1), b2 + hstep, voffB);
            PG8_WAIT_V(6); PG8_BAR; PG8_MMA(1, 1, At, B1); PG8_BAR;
            PG8_LDB(B0, 1, 0); PG8_SCHED; PG8_LDA(At, 1, 0); PG8_STAGE(PG8_SA(0, 1), a2 + hstep, voffA);
            PG8_WAIT_L(8); PG8_BAR; PG8_WAIT_L(0); PG8_MMA(0, 0, At, B0); PG8_BAR; PG8_SCHED;
            PG8_LDB(B1, 1, 1); PG8_STAGE(PG8_SB(1, 0), b3, voffB);
            PG8_BAR; PG8_WAIT_L(0); PG8_MMA(0, 1, At, B1); PG8_BAR;
            PG8_LDA(At, 1, 1); PG8_STAGE(PG8_SA(1, 0), a3, voffA);
            PG8_BAR; PG8_WAIT_L(0); PG8_MMA(1, 0, At, B0); PG8_BAR; PG8_SCHED;
            PG8_STAGE(PG8_SB(1, 1), b3 + hstep, voffB);
            PG8_WAIT_V(6); PG8_BAR; PG8_MMA(1, 1, At, B1); PG8_BAR;
            }
        }
        if constexpr (ALIGN_EPI) { if (wr == 0) PG8_BAR; }
        if constexpr (!Epi::AFTER_DRAIN) { E(acc, cur, wr, wc, fr, fq); S.done(cur); }
        if (!has_next) break;
#pragma unroll
        for (int a = 0; a < 2; ++a)
#pragma unroll
            for (int b = 0; b < 2; ++b)
#pragma unroll
                for (int m = 0; m < 4; ++m)
#pragma unroll
                    for (int n = 0; n < 2; ++n) acc[a][b][m][n] = (f32x4){0.f, 0.f, 0.f, 0.f};
        cur = nxt; cA = nA; cB = nB; ++ui;
        if constexpr (ALIGN_EPI) { if (wr == 1) PG8_BAR; }
    }
    PG8_WAIT_V(0);
    if constexpr (!ALIGN_EPI) { if (wr == 0) PG8_BAR; }
    PG8_BAR;
    if constexpr (Epi::AFTER_DRAIN) { E.fused(acc, cur, wr, wc, fr, fq, lds, wid, lane); S.done(cur); }
#undef PG8_SA
#undef PG8_SB
#undef PG8_STAGE
#undef PG8_LDA
#undef PG8_LDB
#undef PG8_MMA
#undef PG8_WAIT_V
#undef PG8_WAIT_L
#undef PG8_BAR
#undef PG8_SCHED
}
}

namespace att {
#define LAS __attribute__((address_space(3)))
typedef unsigned short bf16_t;
typedef short bf16x8 __attribute__((ext_vector_type(8)));
typedef float f32x16 __attribute__((ext_vector_type(16)));
typedef float f32x4 __attribute__((ext_vector_type(4)));
typedef unsigned u32x4 __attribute__((ext_vector_type(4)));
typedef _Float16 f16x8 __attribute__((ext_vector_type(8)));
constexpr float LOG2E = 1.4426950408889634f;
constexpr float NEG_BIG = -1.0e30f;
__device__ __forceinline__ int pi32(int m) { return (m & 0x13) | ((m & 4) << 1) | ((m & 8) >> 1); }
__device__ __forceinline__ unsigned cvtpk(float lo, float hi) { unsigned r; asm volatile("v_cvt_pk_bf16_f32 %0, %1, %2" : "=v"(r) : "v"(lo), "v"(hi)); return r; }
__device__ __forceinline__ float bflo(unsigned w) { return __uint_as_float(w << 16); }
__device__ __forceinline__ float bfhi(unsigned w) { return __uint_as_float(w & 0xffff0000u); }
__device__ __forceinline__ void unpack8(const u32x4 r, float (&x)[8]) {
    x[0] = bflo(r.x); x[1] = bfhi(r.x); x[2] = bflo(r.y); x[3] = bfhi(r.y); x[4] = bflo(r.z); x[5] = bfhi(r.z); x[6] = bflo(r.w); x[7] = bfhi(r.w);
}
__device__ __forceinline__ u32x4 pack8(const float (&x)[8]) { u32x4 w; w.x = cvtpk(x[0], x[1]); w.y = cvtpk(x[2], x[3]); w.z = cvtpk(x[4], x[5]); w.w = cvtpk(x[6], x[7]); return w; }

template <int DK, int NDB, int NSPLIT, int TK = 64> struct Cfg {
    static constexpr int NPB = (NDB == 2 || (NDB == 4 && NSPLIT == 1)) ? 2 : 1;
    static constexpr int KS = DK * 2 + 16, KBUF = TK * KS, DVT = 32 * NDB * NSPLIT, VSB = TK * 2 + 16, VBUF = DVT * VSB, XOFF = 2 * NPB * (KBUF + VBUF);
    static constexpr int PPR = DK / 8, RPI = 512 / PPR, NKL = TK / RPI;
    static constexpr int PV = TK / 8, RVI = 512 / PV, NVL = DVT / RVI;
    static constexpr int NSB = TK / 32, NKS = TK / 16;
};

template <int DK, int NDB, int NSPLIT, int MODE, int TK>
__device__ __forceinline__ void attn_core(LAS unsigned char* lds, const int tid,
        const bf16_t* Qrow, const LAS float* gq, const LAS float* gk,
        const bf16_t* Kbase, const int kpitch, const bf16_t* VTbase, const int vtpitch,
        const int kt0, const int kt1, const int wlo, const int whi, const int diag,
        const int qidx, const float* CSq, const _Float16* CSk, const int dsplit, const bool bounded,
        f32x16 (&O)[NDB], float& lsum_out) {
    typedef Cfg<DK, NDB, NSPLIT, TK> C;
    const int lane = tid & 63, hi = lane >> 5, q31 = lane & 31, pim = pi32(q31);
    bf16x8 qf[DK / 16];
#define ATT_QPROLOGUE() do { \
        u32x4 qraw_[DK / 16]; \
        _Pragma("unroll") for (int d0 = 0; d0 < DK / 16; ++d0) qraw_[d0] = *(const u32x4*)(Qrow + 16 * d0 + 8 * hi); \
        f32x4 cq_[4]; \
        if (MODE == 1) { _Pragma("unroll") for (int i_ = 0; i_ < 4; ++i_) cq_[i_] = *(const f32x4*)(CSq + 4 * i_); } \
        float ss = 0.f; \
        _Pragma("unroll") for (int d0 = 0; d0 < DK / 16; ++d0) { float x[8]; unpack8(qraw_[d0], x); \
            _Pragma("unroll") for (int e = 0; e < 8; ++e) ss += x[e] * x[e]; } \
        ss += __shfl_xor(ss, 32); \
        const float rs = rsqrtf(ss * (1.0f / DK) + 1e-6f) * (rsqrtf((float)DK) * LOG2E); \
        _Pragma("unroll") for (int d0 = 0; d0 < DK / 16; ++d0) { float x[8]; unpack8(qraw_[d0], x); \
            const f32x4 g0 = *(const LAS f32x4*)(gq + 16 * d0 + 8 * hi), g1 = *(const LAS f32x4*)(gq + 16 * d0 + 8 * hi + 4); \
            _Pragma("unroll") for (int e = 0; e < 4; ++e) { x[e] *= rs * g0[e]; x[4 + e] *= rs * g1[e]; } \
            if (MODE == 1 && d0 == 0) { \
                _Pragma("unroll") for (int e = 0; e < 8; ++e) { const float xp = __shfl_xor(x[e], 32); const float c = cq_[e >> 2][e & 3], sn = cq_[2 + (e >> 2)][e & 3]; x[e] = hi ? (x[e] * c + xp * sn) : (x[e] * c - xp * sn); } \
            } \
            const u32x4 w = pack8(x); qf[d0] = __builtin_bit_cast(bf16x8, w); } \
    } while (0)
    const int kpiece = tid % C::PPR, krow = tid / C::PPR, vpiece = tid % C::PV, vrow = tid / C::PV;
    const unsigned koff = (unsigned)(krow * kpitch * 2 + kpiece * 16), voff = (unsigned)(vrow * vtpitch * 2 + vpiece * 16);
    const unsigned klds = (unsigned)(krow * C::KS + kpiece * 16), vlds = (unsigned)(2 * C::NPB * C::KBUF + vrow * C::VSB + vpiece * 16);
    constexpr bool DEEP = (C::NPB == 2);
    constexpr int NP = DEEP ? 2 : 1;
    constexpr int PVB = (NDB <= 2) ? 2 : 1, KFB = (MODE == 1) ? 2 : 4;
    u32x4 kr[NP][C::NKL], vr[NP][C::NVL];
#define ATT_GLD(dst, ptr) do { dst = *(const u32x4*)(ptr); } while (0)
#define ATT_LOAD(st, kt) do { \
    _Pragma("unroll") for (int i_ = 0; i_ < C::NKL; ++i_) { const char* kbp_ = (const char*)(Kbase + (size_t)((kt) * TK + i_ * C::RPI) * kpitch); ATT_GLD(kr[st][i_], kbp_ + koff); } \
    _Pragma("unroll") for (int i_ = 0; i_ < C::NVL; ++i_) { const char* vbp_ = (const char*)(VTbase + (size_t)(i_ * C::RVI) * vtpitch + (kt) * TK); ATT_GLD(vr[st][i_], vbp_ + voff); } } while (0)
#define ATT_WAIT(st, newer) do { } while (0)
#define ATT_STORE(st, kt, buf) do { \
    _Pragma("unroll") for (int i_ = 0; i_ < C::NKL; ++i_) { *(LAS u32x4*)(lds + (buf) * C::KBUF + i_ * C::RPI * C::KS + klds) = kr[st][i_]; } \
    _Pragma("unroll") for (int i_ = 0; i_ < C::NVL; ++i_) { *(LAS u32x4*)(lds + (buf) * C::VBUF + i_ * C::RVI * C::VSB + vlds) = vr[st][i_]; } } while (0)

#pragma unroll
    for (int db = 0; db < NDB; ++db)
#pragma unroll
        for (int r = 0; r < 16; ++r) O[db][r] = 0.f;
    constexpr float THR = 16.0f;
    constexpr bool LMFMA = (NDB <= 2);
    float lsum = 0.f;
    f32x16 lacc;
    if (LMFMA) {
#pragma unroll
        for (int r = 0; r < 16; ++r) lacc[r] = 0.f;
    }
    const bf16x8 onesf = {(short)0x3F80, (short)0x3F80, (short)0x3F80, (short)0x3F80, (short)0x3F80, (short)0x3F80, (short)0x3F80, (short)0x3F80};
    float Fq = 0.f;
    if (MODE == 0) Fq = ((const LAS float*)(lds + C::XOFF))[qidx];
    f32x16 cinit;
    float moff = 0.f;
    if (MODE == 0) {
#pragma unroll
        for (int r = 0; r < 16; ++r) cinit[r] = Fq;
    }
    ATT_LOAD(0, kt0);
    if (DEEP) ATT_LOAD(1, kt0 + 1);
    ATT_QPROLOGUE();
    ATT_STORE(0, kt0, 0);
    if (DEEP) ATT_STORE(1, kt0 + 1, 1);
    __syncthreads();
    int cur = 0;
#pragma unroll 1
    for (int kt2 = kt0; kt2 < kt1; kt2 += NP) {
#pragma unroll
      for (int p = 0; p < NP; ++p) {
        const int kt = kt2 + p;
        if (kt < kt1) {
        const bool more = DEEP ? (kt2 + 2 < kt1) : (kt + 1 < kt1);
        if (DEEP && p == 0 && more) { ATT_LOAD(0, kt2 + 2); ATT_LOAD(1, kt2 + 3); }
        if (!DEEP && MODE == 1 && more) ATT_LOAD(0, kt + 1);
        if (kt >= wlo && kt <= whi) {
            const LAS unsigned char* kb = lds + (cur * NP + p) * C::KBUF + pim * C::KS + hi * 16;
            f32x16 s[C::NSB];
#pragma unroll
            for (int dg = 0; dg < DK / (16 * KFB); ++dg) {
                bf16x8 kf[C::NSB][KFB];
#pragma unroll
                for (int dd = 0; dd < KFB; ++dd)
#pragma unroll
                    for (int sb = 0; sb < C::NSB; ++sb) kf[sb][dd] = *(const LAS bf16x8*)(kb + sb * 32 * C::KS + (dg * KFB + dd) * 32);
                __builtin_amdgcn_sched_barrier(0);
#pragma unroll
                for (int dd = 0; dd < KFB; ++dd)
#pragma unroll
                    for (int sb = 0; sb < C::NSB; ++sb) {
                        const int d0 = dg * KFB + dd;
                        if (d0 == 0) { if (MODE == 0) s[sb] = __builtin_amdgcn_mfma_f32_32x32x16_bf16(kf[sb][dd], qf[d0], cinit, 0, 0, 0);
                                       else { f32x16 z;
#pragma unroll
                                              for (int r = 0; r < 16; ++r) z[r] = 0.f;
                                              s[sb] = __builtin_amdgcn_mfma_f32_32x32x16_bf16(kf[sb][dd], qf[d0], z, 0, 0, 0); } }
                        else s[sb] = __builtin_amdgcn_mfma_f32_32x32x16_bf16(kf[sb][dd], qf[d0], s[sb], 0, 0, 0);
                    }
                __builtin_amdgcn_sched_barrier(0);
            }
            if (MODE == 3 && more) { ATT_LOAD(0, kt + 1); __builtin_amdgcn_sched_barrier(0); }
            if (MODE == 0) {
                const LAS float* Fl = (const LAS float*)(lds + C::XOFF);
                const int kb0 = kt * TK + 8 * hi;
#pragma unroll
                for (int sb = 0; sb < C::NSB; ++sb)
#pragma unroll
                    for (int a = 0; a < 2; ++a) {
                        const f32x4 f0 = *(const LAS f32x4*)(Fl + kb0 + 32 * sb + 16 * a), f1 = *(const LAS f32x4*)(Fl + kb0 + 32 * sb + 16 * a + 4);
#pragma unroll
                        for (int e = 0; e < 4; ++e) { s[sb][8 * a + e] -= f0[e]; s[sb][8 * a + 4 + e] -= f1[e]; }
                    }
                if (kt == diag) {
#pragma unroll
                    for (int sb = 0; sb < C::NSB; ++sb)
#pragma unroll
                        for (int r = 0; r < 16; ++r) { const int key = kb0 + 32 * sb + 16 * (r >> 3) + (r & 7); if (key > qidx) s[sb][r] = NEG_BIG; }
                }
            }
            if (MODE == 2) {
                const LAS float* tab = (const LAS float*)(lds + C::XOFF);
                if (kt + 2 >= diag) {
                    const int rel0 = qidx - (kt * TK + 8 * hi);
#pragma unroll
                    for (int sb = 0; sb < C::NSB; ++sb)
#pragma unroll
                        for (int r = 0; r < 16; ++r) { const int rel = rel0 - (32 * sb + 16 * (r >> 3) + (r & 7));
                            const int i0 = min(max(rel, -128), 128) + 128; s[sb][r] += tab[i0]; }
                } else {
                    const float c = tab[256];
#pragma unroll
                    for (int sb = 0; sb < C::NSB; ++sb)
#pragma unroll
                        for (int r = 0; r < 16; ++r) s[sb][r] += c;
                }
            }
            if (!bounded) {
                if (MODE != 0 && __any(moff != 0.f)) {
#pragma unroll
                    for (int sb = 0; sb < C::NSB; ++sb)
#pragma unroll
                        for (int r = 0; r < 16; ++r) s[sb][r] -= moff;
                }
                float mx = fmaxf(fmaxf(s[0][0], s[0][1]), s[0][2]);
#pragma unroll
                for (int sb = 0; sb < C::NSB; ++sb)
#pragma unroll
                    for (int r = (sb == 0 ? 3 : 0); r + 1 < 16; r += 2) mx = fmaxf(fmaxf(mx, s[sb][r]), s[sb][r + 1]);
                mx = fmaxf(mx, s[0][15]);
                mx = fmaxf(mx, __shfl_xor(mx, 32));
                if (__any(mx > THR)) {
                    const float dl = fmaxf(mx, 0.f), f = __builtin_amdgcn_exp2f(-dl);
#pragma unroll
                    for (int sb = 0; sb < C::NSB; ++sb)
#pragma unroll
                        for (int r = 0; r < 16; ++r) s[sb][r] -= dl;
                    if (MODE == 0) {
#pragma unroll
                        for (int r = 0; r < 16; ++r) cinit[r] -= dl;
                    } else moff += dl;
                    lsum *= f;
                    if (LMFMA) {
#pragma unroll
                        for (int r = 0; r < 16; ++r) lacc[r] *= f;
                    }
#pragma unroll
                    for (int db = 0; db < NDB; ++db)
#pragma unroll
                        for (int r = 0; r < 16; ++r) O[db][r] *= f;
                }
            }
            if (LMFMA) {
#pragma unroll
                for (int sb = 0; sb < C::NSB; ++sb)
#pragma unroll
                    for (int r = 0; r < 16; ++r) s[sb][r] = __builtin_amdgcn_exp2f(s[sb][r]);
            } else {
                float ps = 0.f;
#pragma unroll
                for (int sb = 0; sb < C::NSB; ++sb)
#pragma unroll
                    for (int r = 0; r < 16; ++r) { s[sb][r] = __builtin_amdgcn_exp2f(s[sb][r]); ps += s[sb][r]; }
                lsum += ps;
            }
            const LAS unsigned char* vb = lds + 2 * NP * C::KBUF + (cur * NP + p) * C::VBUF + (dsplit * 32 * NDB + pim) * C::VSB + hi * 16;
#pragma unroll
            for (int kg = 0; kg < C::NKS / PVB; ++kg) {
                bf16x8 vf[PVB][NDB];
#pragma unroll
                for (int k2 = 0; k2 < PVB; ++k2)
#pragma unroll
                    for (int db = 0; db < NDB; ++db) vf[k2][db] = *(const LAS bf16x8*)(vb + db * 32 * C::VSB + (PVB * kg + k2) * 32);
                u32x4 pw[PVB];
#pragma unroll
                for (int k2 = 0; k2 < PVB; ++k2) { const int ks = PVB * kg + k2, sb = ks >> 1, r0 = 8 * (ks & 1);
                    pw[k2].x = cvtpk(s[sb][r0 + 0], s[sb][r0 + 1]); pw[k2].y = cvtpk(s[sb][r0 + 2], s[sb][r0 + 3]); pw[k2].z = cvtpk(s[sb][r0 + 4], s[sb][r0 + 5]); pw[k2].w = cvtpk(s[sb][r0 + 6], s[sb][r0 + 7]); }
                __builtin_amdgcn_sched_barrier(0);
#pragma unroll
                for (int k2 = 0; k2 < PVB; ++k2)
#pragma unroll
                    for (int db = 0; db < NDB; ++db)
                        O[db] = __builtin_amdgcn_mfma_f32_32x32x16_bf16(vf[k2][db], __builtin_bit_cast(bf16x8, pw[k2]), O[db], 0, 0, 0);
                if (LMFMA) {
#pragma unroll
                    for (int k2 = 0; k2 < PVB; ++k2) lacc = __builtin_amdgcn_mfma_f32_32x32x16_bf16(onesf, __builtin_bit_cast(bf16x8, pw[k2]), lacc, 0, 0, 0);
                }
                __builtin_amdgcn_sched_barrier(0);
            }
        }
        if (DEEP) { if (p == 1) { if (more) { ATT_STORE(0, kt2 + 2, (cur ^ 1) * 2); ATT_STORE(1, kt2 + 3, (cur ^ 1) * 2 + 1); } __syncthreads(); cur ^= 1; } }
        else { if (more) ATT_STORE(0, kt + 1, cur ^ 1); __syncthreads(); cur ^= 1; }
        }
      }
    }
    if (LMFMA) lsum = lacc[0];
    else lsum += __shfl_xor(lsum, 32);
    lsum_out = lsum;
#undef ATT_LOAD
#undef ATT_GLD
#undef ATT_WAIT
#undef ATT_STORE
#undef ATT_QPROLOGUE
}

template <int NDB>
__device__ __forceinline__ void store_o(bf16_t* orow, const f32x16 (&O)[NDB], const float inv, const int hi) {
#pragma unroll
    for (int db = 0; db < NDB; ++db)
#pragma unroll
        for (int a = 0; a < 2; ++a) {
            u32x4 w; w.x = cvtpk(O[db][8 * a + 0] * inv, O[db][8 * a + 1] * inv); w.y = cvtpk(O[db][8 * a + 2] * inv, O[db][8 * a + 3] * inv);
            w.z = cvtpk(O[db][8 * a + 4] * inv, O[db][8 * a + 5] * inv); w.w = cvtpk(O[db][8 * a + 6] * inv, O[db][8 * a + 7] * inv);
            *(u32x4*)(orow + 32 * db + 16 * a + 8 * hi) = w;
        }
}
}
__device__ __forceinline__ float bf2f_u(unsigned short v) { return __uint_as_float((unsigned)v << 16); }

namespace cg = cooperative_groups;
#ifndef MK_SINGLE
#define MK_SINGLE 1
#endif
typedef unsigned short bf16;
typedef unsigned v4u __attribute__((ext_vector_type(4)));
typedef float f32x4 __attribute__((ext_vector_type(4)));
constexpr int NWAVES = 8, NTHREADS = 512;
constexpr int DM = 1024, NB = 32, SEQ = 2048, M = NB * SEQ, DEPTH = 4, DFF = 2816, NMEM = 256, MMEM = NB * NMEM;
constexpr int PP = 2560;
constexpr size_t MiB = 1u << 20;
constexpr size_t WS_SS = 1 * MiB, WS_SSMEM = 6 * MiB, WS_CS = 7 * MiB, WS_CSH = 11 * MiB, WS_W = 16 * MiB;
constexpr int GOFF = 143360;
constexpr size_t W_LAYER = 45 * MiB + MiB / 2;
constexpr size_t WO_1IN = 0, WO_1OUT = 11 * MiB, WO_2IN = 16 * MiB + MiB / 2, WO_2OUT = 27 * MiB + MiB / 2, WO_MIXIN = 33 * MiB, WO_MIXOUT = 39 * MiB + MiB / 2, WO_XQ = 41 * MiB + MiB / 2, WO_XO = 43 * MiB + MiB / 2;
constexpr size_t WS_WKV = WS_W + 4 * W_LAYER;
constexpr size_t WS_XB = 216 * MiB, WS_MEMB = 344 * MiB, WS_KX = 360 * MiB, WS_VXT = 376 * MiB, WS_R1 = 392 * MiB;
constexpr size_t WS_H = WS_R1, WS_P = WS_R1, WS_VT = WS_R1 + 320 * MiB, WS_OMIX = WS_VT + 128 * MiB, WS_QX = WS_R1, WS_OX = WS_R1 + 128 * MiB;
constexpr size_t WS_STASH = WS_OMIX + 128 * MiB;
constexpr size_t WS_END = WS_STASH + 32 * MiB;
static_assert(WS_WKV + 16 * MiB <= WS_XB && WS_H + (size_t)M * DFF * 2 <= WS_STASH && WS_P + (size_t)M * PP * 2 <= WS_VT, "ws map");
constexpr int LDS_BYTES = 147456;

struct Args {
    const float* in[23]; float* out; unsigned char* ws; double inv[8]; int ph_lo, ph_hi, zero_alpha, pad;
};

#define LDS_WAIT() asm volatile("s_waitcnt lgkmcnt(0)" ::: "memory")
__device__ __forceinline__ unsigned f2bf(float f) { unsigned u = __builtin_bit_cast(unsigned, f); return (u + 0x7fffu + ((u >> 16) & 1u)) >> 16; }
__device__ __forceinline__ unsigned pk2(float lo, float hi) { return f2bf(lo) | (f2bf(hi) << 16); }
__device__ __forceinline__ float wave_sum(float v) {
#pragma unroll
    for (int o = 1; o < 64; o <<= 1) v += __shfl_xor(v, o);
    return v;
}

__device__ __forceinline__ unsigned pkh2(float lo, float hi) { typedef _Float16 h2 __attribute__((ext_vector_type(2))); const h2 v = {(_Float16)lo, (_Float16)hi}; return __builtin_bit_cast(unsigned, v); }
__device__ __forceinline__ void p0_item_map(int it, int nnb, int Nsrc, int maptype, int& k0, int& n0, int& srcc0, int& nvalid) {
    const int kb = it / nnb, nb = it % nnb; k0 = kb * 64; n0 = nb * 32; srcc0 = n0; nvalid = 32;
    if (maptype == 0) { nvalid = Nsrc - n0; nvalid = nvalid < 0 ? 0 : (nvalid > 32 ? 32 : nvalid); }
    else if (maptype == 1) { const int tile = n0 >> 8, r = n0 & 255; srcc0 = (r < 128) ? tile * 128 + r : DFF + tile * 128 + (r - 128); }
    else {
        if (n0 < 1024) srcc0 = n0;
        else if (n0 < 2048) srcc0 = 1544 + (n0 - 1024);
        else if (n0 < 2304) { srcc0 = 1536 + (n0 - 2048); nvalid = (n0 == 2048) ? 8 : 0; if (nvalid == 0) srcc0 = 0; }
        else if (n0 < 2816) srcc0 = 1024 + (n0 - 2304);
        else srcc0 = 2568 + (n0 - 2816);
    }
}
__device__ __forceinline__ void p0_item_load(const float* W, int Nsrc, int k0, int srcc0, int nvalid, int lane, f32x4 (&wv)[8]) {
    const int c4 = lane & 7, r8 = lane >> 3;
#pragma unroll
    for (int i = 0; i < 8; ++i) { const int kk = 8 * i + r8;
        wv[i] = (4 * c4 < nvalid) ? *(const f32x4*)(W + (size_t)(k0 + kk) * Nsrc + srcc0 + 4 * c4) : (f32x4){0.f, 0.f, 0.f, 0.f}; }
}
__device__ __forceinline__ void p0_item_finish(const f32x4 (&wv)[8], int K, bf16* WT, int n0, const float* gain, LAS float* scr, int k0, int lane, bool f16) {
    const float gl = gain ? gain[k0 + lane] : 1.0f;
    const int c4 = lane & 7, r8 = lane >> 3;
#pragma unroll
    for (int i = 0; i < 8; ++i) { const int kk = 8 * i + r8; const float gk_ = __shfl(gl, kk); LAS float* d = scr + kk * 33 + 4 * c4;
        d[0] = wv[i][0] * gk_; d[1] = wv[i][1] * gk_; d[2] = wv[i][2] * gk_; d[3] = wv[i][3] * gk_; }
    LDS_WAIT();
    const int c8 = lane & 7;
#pragma unroll
    for (int j = 0; j < 4; ++j) { const int n = (lane >> 3) + 8 * j; const LAS float* s = scr + (8 * c8) * 33 + n;
        v4u o;
        if (f16) { o.x = pkh2(s[0 * 33], s[1 * 33]); o.y = pkh2(s[2 * 33], s[3 * 33]); o.z = pkh2(s[4 * 33], s[5 * 33]); o.w = pkh2(s[6 * 33], s[7 * 33]); }
        else { o.x = pk2(s[0 * 33], s[1 * 33]); o.y = pk2(s[2 * 33], s[3 * 33]); o.z = pk2(s[4 * 33], s[5 * 33]); o.w = pk2(s[6 * 33], s[7 * 33]); }
        *(v4u*)(WT + (size_t)(n0 + n) * K + k0 + 8 * c8) = o; }
    LDS_WAIT();
}

__device__ __forceinline__ void p0_matrix(const float* W, int K, int Nsrc, bf16* WT, int Ndst, int maptype, const float* gain, LAS float* scr, int gw, int NGW, int lane, bool f16) {
    const int nkb = K / 64, nnb = Ndst / 32, items = nkb * nnb;
    int it = gw; if (it >= items) return;
    int k0, n0, srcc0, nvalid; f32x4 cur[8], nxt[8];
    p0_item_map(it, nnb, Nsrc, maptype, k0, n0, srcc0, nvalid);
    p0_item_load(W, Nsrc, k0, srcc0, nvalid, lane, cur);
    for (;;) {
        const int itn = it + NGW; const bool more = itn < items; int k0n = 0, n0n = 0, srcn = 0, nvn = 0;
        if (more) { p0_item_map(itn, nnb, Nsrc, maptype, k0n, n0n, srcn, nvn); p0_item_load(W, Nsrc, k0n, srcn, nvn, lane, nxt); }
        p0_item_finish(cur, K, WT, n0, gain, scr, k0, lane, f16);
        if (!more) break;
#pragma unroll
        for (int i = 0; i < 8; ++i) cur[i] = nxt[i];
        it = itn; k0 = k0n; n0 = n0n;
    }
}

__device__ __forceinline__ void rows4_to_bf16_ss(const float* x, bf16* xb, float* ssp, _Float16* xh, int m0, int stride, int lane, int nrows) {
    f32x4 v[4][4];
#pragma unroll
    for (int r = 0; r < 4; ++r)
#pragma unroll
        for (int j = 0; j < 4; ++j) v[r][j] = (m0 + r * stride < nrows) ? ((const f32x4*)(x + (size_t)(m0 + r * stride) * DM))[64 * j + lane] : (f32x4){0.f, 0.f, 0.f, 0.f};
#pragma unroll
    for (int r = 0; r < 4; ++r) { if (m0 + r * stride >= nrows) continue; const size_t row = (size_t)(m0 + r * stride); float s = 0.f;
        unsigned long long* o8 = (unsigned long long*)(xb + row * DM) + lane;
#pragma unroll
        for (int j = 0; j < 4; ++j) { const f32x4 t = v[r][j]; s += (t.x * t.x + t.y * t.y) + (t.z * t.z + t.w * t.w);
            if (xb) o8[64 * j] = (unsigned long long)pk2(t.x, t.y) | ((unsigned long long)pk2(t.z, t.w) << 32);
            if (xh) ((pg8::f16x4*)(xh + row * DM))[64 * j + lane] = (pg8::f16x4){(_Float16)t.x, (_Float16)t.y, (_Float16)t.z, (_Float16)t.w}; }
        s = wave_sum(s);
        if (lane < 16) ssp[row * 16 + lane] = (lane == 0) ? s : 0.f; }
}

__device__ __forceinline__ void sincos_d(double a, float& c, float& s) {
    const double k = rint(a * 0.15915494309189535);
    const float r = (float)fma(-k, 6.283185307179586, a);
    const float r2 = r * r;
    float ps = 1.9572941e-20f;
    ps = fmaf(ps, r2, -8.2206352e-18f);
    ps = fmaf(ps, r2, 2.8114573e-15f);
    ps = fmaf(ps, r2, -7.6471637e-13f);
    ps = fmaf(ps, r2, 1.6059044e-10f);
    ps = fmaf(ps, r2, -2.5052108e-8f);
    ps = fmaf(ps, r2, 2.7557319e-6f);
    ps = fmaf(ps, r2, -1.9841270e-4f);
    ps = fmaf(ps, r2, 8.3333333e-3f);
    ps = fmaf(ps, r2, -1.6666667e-1f);
    ps = fmaf(ps, r2, 1.0f);
    float pc = -8.8967791e-22f;
    pc = fmaf(pc, r2, 4.1103176e-19f);
    pc = fmaf(pc, r2, -1.5619207e-16f);
    pc = fmaf(pc, r2, 4.7794773e-14f);
    pc = fmaf(pc, r2, -1.1470746e-11f);
    pc = fmaf(pc, r2, 2.0876757e-9f);
    pc = fmaf(pc, r2, -2.7557319e-7f);
    pc = fmaf(pc, r2, 2.4801587e-5f);
    pc = fmaf(pc, r2, -1.3888889e-3f);
    pc = fmaf(pc, r2, 4.1666667e-2f);
    pc = fmaf(pc, r2, -0.5f);
    pc = fmaf(pc, r2, 1.0f);
    s = ps * r; c = pc;
}

struct Ptrs {
    const float *x, *mem; const int* pos; const float *ln_g, *f1in, *f1out, *f2in, *f2out, *e_win, *e_fb, *e_qkg, *e_lam, *e_sub, *e_wout, *o_win, *o_conv, *o_qkg, *o_rel, *o_wout, *xwq, *xwkv, *xqkg, *xwo;
};

__device__ __forceinline__ void p0_prologue(const Ptrs& I, const Args& A, unsigned char* ws, LAS unsigned char* lds, int tid_in, float* xh_out) {
    int tid = tid_in; asm volatile("" : "+v"(tid));
    const int lane = tid & 63, wave = tid >> 6;
    LAS float* scr = (LAS float*)(lds + wave * 16384);
    const int gw = blockIdx.x * NWAVES + wave, NGW = gridDim.x * NWAVES;
#pragma unroll 1
    for (int id = 0; id < 9 * DEPTH; ++id) {
        const int l = id / 9, kind = id % 9, e = l >> 1; const bool ev = (l & 1) == 0;
        unsigned char* wl = ws + WS_W + (size_t)l * W_LAYER; const float* g = I.ln_g + (size_t)l * 5 * DM;
        const float* W; int K, Nsrc, Ndst, maptype; bf16* WT; const float* gain; bool f16;
        if (kind == 0)      { W = I.f1in + (size_t)l * DM * 2 * DFF; K = DM; Nsrc = 2 * DFF; WT = (bf16*)(wl + WO_1IN); Ndst = 2 * DFF; maptype = 1; gain = g + 0 * DM; f16 = true; }
        else if (kind == 1) { W = I.f1out + (size_t)l * DFF * DM; K = DFF; Nsrc = DM; WT = (bf16*)(wl + WO_1OUT); Ndst = DM; maptype = 0; gain = nullptr; f16 = false; }
        else if (kind == 2) { W = I.f2in + (size_t)l * DM * 2 * DFF; K = DM; Nsrc = 2 * DFF; WT = (bf16*)(wl + WO_2IN); Ndst = 2 * DFF; maptype = 1; gain = g + 4 * DM; f16 = true; }
        else if (kind == 3) { W = I.f2out + (size_t)l * DFF * DM; K = DFF; Nsrc = DM; WT = (bf16*)(wl + WO_2OUT); Ndst = DM; maptype = 0; gain = nullptr; f16 = false; }
        else if (kind == 4) { if (ev) { W = I.e_win + (size_t)e * DM * 3080; Nsrc = 3080; Ndst = 3328; maptype = 2; } else { W = I.o_win + (size_t)e * DM * 3072; Nsrc = 3072; Ndst = 3072; maptype = 0; }
                              K = DM; WT = (bf16*)(wl + WO_MIXIN); gain = g + 1 * DM; f16 = true; }
        else if (kind == 5) { W = (ev ? I.e_wout : I.o_wout) + (size_t)e * DM * DM; K = DM; Nsrc = DM; WT = (bf16*)(wl + WO_MIXOUT); Ndst = DM; maptype = 0; gain = nullptr; f16 = false; }
        else if (kind == 6) { W = I.xwq + (size_t)l * DM * DM; K = DM; Nsrc = DM; WT = (bf16*)(wl + WO_XQ); Ndst = DM; maptype = 0; gain = g + 2 * DM; f16 = true; }
        else if (kind == 7) { W = I.xwo + (size_t)l * DM * DM; K = DM; Nsrc = DM; WT = (bf16*)(wl + WO_XO); Ndst = DM; maptype = 0; gain = nullptr; f16 = false; }
        else                { W = I.xwkv + (size_t)l * DM * 2 * DM; K = DM; Nsrc = 2 * DM; WT = (bf16*)(ws + WS_WKV) + (size_t)l * 2048 * DM; Ndst = 2 * DM; maptype = 0; gain = g + 3 * DM; f16 = true; }
        p0_matrix(W, K, Nsrc, WT, Ndst, maptype, gain, scr, gw, NGW, lane, f16);
    }
    for (int m = gw; m < M; m += 4 * NGW) rows4_to_bf16_ss(I.x, nullptr, (float*)(ws + WS_SS), (_Float16*)xh_out, m, NGW, lane, M);
    for (int m = gw; m < MMEM; m += 4 * NGW) rows4_to_bf16_ss(I.mem, nullptr, (float*)(ws + WS_SSMEM), (_Float16*)(ws + WS_MEMB), m, NGW, lane, MMEM);
    float* cs = (float*)(ws + WS_CS);
    for (int it = blockIdx.x * NTHREADS + tid; it < M * 8; it += gridDim.x * NTHREADS) {
        const int m = it >> 3, i = it & 7; float c, s; sincos_d((double)I.pos[m] * A.inv[i], c, s);
        cs[(size_t)m * 16 + i] = c; cs[(size_t)m * 16 + 8 + i] = s;
        _Float16* csh = (_Float16*)(ws + WS_CSH); csh[(size_t)m * 16 + i] = (_Float16)c; csh[(size_t)m * 16 + 8 + i] = (_Float16)s;
    }
}

__device__ __forceinline__ float grp_sum(float v, int n) { for (int o = 1; o < n; o <<= 1) v += __shfl_xor(v, o); return v; }
__device__ __forceinline__ void kprep_phase(unsigned char* ws, int tid_in, int kind, const float* gains, const int*  ) {
    using namespace att;
    int tid = tid_in; asm volatile("" : "+v"(tid));
    const int lane = tid & 63, wave = tid >> 6;
    const int gw = blockIdx.x * NWAVES + wave, NGW = gridDim.x * NWAVES;
    if (kind == 2) {
        bf16* KX = (bf16*)(ws + WS_KX);
        float g0[8];
#pragma unroll
        for (int e = 0; e < 8; ++e) g0[e] = gains[256 + (lane & 31) * 8 + e];
        for (int m = gw; m < MMEM; m += 4 * NGW) {
            u32x4 ra[4], rb[4];
#pragma unroll
            for (int r = 0; r < 4; ++r) { const int row = m + r * NGW; const bool ok = row < MMEM; const bf16* rp = KX + (size_t)(ok ? row : 0) * DM + lane * 8;
                ra[r] = *(const u32x4*)rp; rb[r] = *(const u32x4*)(rp + 512); }
#pragma unroll
            for (int r = 0; r < 4; ++r) { const int row = m + r * NGW; if (row >= MMEM) continue; bf16* rp = KX + (size_t)row * DM + lane * 8;
                float x0[8], x1[8]; unpack8(ra[r], x0); unpack8(rb[r], x1); float s0 = 0.f, s1 = 0.f;
#pragma unroll
                for (int e = 0; e < 8; ++e) { s0 += x0[e] * x0[e]; s1 += x1[e] * x1[e]; }
                s0 = grp_sum(s0, 32); s1 = grp_sum(s1, 32);
                const float q0 = rsqrtf(s0 * (1.0f / 256.0f) + 1e-6f), q1 = rsqrtf(s1 * (1.0f / 256.0f) + 1e-6f);
#pragma unroll
                for (int e = 0; e < 8; ++e) { x0[e] *= q0 * g0[e]; x1[e] *= q1 * g0[e]; }
                *(u32x4*)rp = pack8(x0); *(u32x4*)(rp + 512) = pack8(x1); }
        }
    } else {
        bf16* P = (bf16*)(ws + WS_P);
        const _Float16* CSH = (const _Float16*)(ws + WS_CSH);
        const int pc = lane & 7, c0 = (kind == 0 ? 512 : 2048) + lane * 8;
        float ga[8], gb[8];
#pragma unroll
        for (int e = 0; e < 8; ++e) { ga[e] = gains[64 + pc * 8 + e]; gb[e] = (kind == 0) ? gains[192 + pc * 8 + e] : 0.f; }
        for (int m = gw; m < M; m += 4 * NGW) {
            u32x4 ra[4], rb[4], ca[4], cb[4];
#pragma unroll
            for (int r = 0; r < 4; ++r) { const int row = m + r * NGW; const bool ok = row < M; const bf16* rp = P + (size_t)(ok ? row : 0) * PP + c0;
                ra[r] = *(const u32x4*)rp;
                if (kind == 0) { rb[r] = *(const u32x4*)(rp + 1024); const u32x4* cp = (const u32x4*)(CSH + (size_t)(ok ? row : 0) * 16); ca[r] = cp[0]; cb[r] = cp[1]; } }
#pragma unroll
            for (int r = 0; r < 4; ++r) { const int row = m + r * NGW; if (row >= M) continue; bf16* rp = P + (size_t)row * PP + c0;
                float x0[8]; unpack8(ra[r], x0); float s0 = 0.f;
#pragma unroll
                for (int e = 0; e < 8; ++e) s0 += x0[e] * x0[e];
                s0 = grp_sum(s0, 8);
                const float q0 = rsqrtf(s0 * (1.0f / 64.0f) + 1e-6f);
#pragma unroll
                for (int e = 0; e < 8; ++e) x0[e] *= q0 * ga[e];
                if (kind == 0) {
                    const f16x8 ch = __builtin_bit_cast(f16x8, ca[r]), sh = __builtin_bit_cast(f16x8, cb[r]);
                    float x1[8]; unpack8(rb[r], x1); float s1 = 0.f;
#pragma unroll
                    for (int e = 0; e < 8; ++e) s1 += x1[e] * x1[e];
                    s1 = grp_sum(s1, 8);
                    const float q1 = rsqrtf(s1 * (1.0f / 64.0f) + 1e-6f);
#pragma unroll
                    for (int e = 0; e < 8; ++e) { x1[e] *= q1 * gb[e]; const float xp = __shfl_xor(x1[e], 1); const float c = (float)ch[e], sn = (float)sh[e];
                        const float rA = x1[e] * c - xp * sn, rB = x1[e] * c + xp * sn; x1[e] = (pc == 0) ? rA : ((pc == 1) ? rB : x1[e]); }
                    *(u32x4*)(rp + 1024) = pack8(x1);
                }
                *(u32x4*)rp = pack8(x0); }
        }
    }
}

__device__ __forceinline__ int vcu_index() { const int G = gridDim.x, bx = blockIdx.x; return (G % 8 == 0) ? (bx % 8) * (G / 8) + bx / 8 : bx; }
__device__ __forceinline__ float lds_absmax(const LAS float* p, int n, int lane) {
    float v = 0.f; for (int i = lane; i < n; i += 64) v = fmaxf(v, fabsf(p[i]));
#pragma unroll
    for (int o = 1; o < 64; o <<= 1) v = fmaxf(v, __shfl_xor(v, o));
    return v;
}

__device__ __forceinline__ float log_sigmoid(float z) { return (z >= 0.f) ? -log1pf(__expf(-z)) : (z - log1pf(__expf(z))); }

__device__ __forceinline__ void attn_even_phase(const Ptrs& I, unsigned char* ws, LAS unsigned char* lds, int tid_in, int layer, float* stash_base) {
    int tid = tid_in; asm volatile("" : "+v"(tid));
    using namespace att;
    const int lane = tid & 63, wave = __builtin_amdgcn_readfirstlane(tid >> 6), hi = lane >> 5, q31 = lane & 31, e = layer >> 1;
    const bf16* P = (const bf16*)(ws + WS_P); const bf16* VT = (const bf16*)(ws + WS_VT); bf16* OM = (bf16*)(ws + WS_OMIX);
    const float* CS = (const float*)(ws + WS_CS);
    const float* qkg_g = I.e_qkg + (size_t)e * 4 * 64;
    LAS float* qkg = (LAS float*)(lds + GOFF);
    const _Float16* CSH = (const _Float16*)(ws + WS_CSH);
    if (tid < 256) qkg[tid] = qkg_g[tid];
    __syncthreads();
    const bool bndA = 8.0f * att::LOG2E * lds_absmax(qkg, 64, lane) * lds_absmax(qkg + 64, 64, lane) < 60.0f;
    const bool bndB = 8.0f * att::LOG2E * lds_absmax(qkg + 128, 64, lane) * lds_absmax(qkg + 192, 64, lane) < 60.0f;
    for (int v = vcu_index(); v < 256; v += gridDim.x) {
        {
            const int b = v >> 3, h = v & 7;
            typedef Cfg<64, 2, 1> C0;
            LAS float* Fl = (LAS float*)(lds + C0::XOFF); LAS float* wsum = (LAS float*)(lds + C0::XOFF + 8192);
            {
                const float fb = I.e_fb[e * 8 + h]; float vv[4]; float run = 0.f;
#pragma unroll
                for (int j = 0; j < 4; ++j) { const int t = 4 * tid + j; const float af = bf2f_u(P[(size_t)(b * SEQ + t) * PP + 2048 + h]); run += log_sigmoid(af + fb); vv[j] = run; }
                float inc = run;
#pragma unroll
                for (int o = 1; o < 64; o <<= 1) { const float n = __shfl_up(inc, o); if (lane >= o) inc += n; }
                if (lane == 63) wsum[wave] = inc;
                __syncthreads();
                float base = inc - run;
                for (int w = 0; w < wave; ++w) base += wsum[w];
#pragma unroll
                for (int j = 0; j < 4; ++j) Fl[4 * tid + j] = (base + vv[j]) * LOG2E;
                __syncthreads();
            }
#pragma unroll 1
            for (int qb = 0; qb < 8; ++qb) {
                const int c = 4 * qb + (wave >> 1), qidx = 256 * qb + 32 * wave + q31; const size_t row = (size_t)b * SEQ + qidx;
                f32x16 O[2]; float l;
                attn_core<64, 2, 1, 0, 64>(lds, tid, P + row * PP + h * 64, qkg, qkg + 64, P + (size_t)b * SEQ * PP + 512 + h * 64, PP,
                                       VT + (size_t)(b * 512 + h * 64) * SEQ, SEQ, 0, 4 * qb + 4, 0, c, c, qidx, nullptr, nullptr, 0, bndA, O, l);
                store_o<2>(OM + row * DM + h * 64, O, 1.0f / l, hi);
            }
        }
        {
            asm volatile("" : "+v"(tid));
            const int pr = v >> 1, b = pr >> 2, h = pr & 3, odd = v & 1;
            const float lam_init = 0.8f - 0.6f * __expf(-0.3f * (float)layer);
            float lam;
            { const float* lp = I.e_lam + (size_t)e * 4 * 64; const float sa = wave_sum(lp[lane] * lp[64 + lane]), sb = wave_sum(lp[128 + lane] * lp[192 + lane]); lam = __expf(sa) - __expf(sb) + lam_init; }
            const float* sub = I.e_sub + (size_t)e * 128;
#pragma unroll 1
            for (int qi = 0; qi < 4; ++qi) {
                const int qb = odd ? ((qi == 0) ? 1 : (qi == 1) ? 2 : (qi == 2) ? 5 : 6) : ((qi == 0) ? 0 : (qi == 1) ? 3 : (qi == 2) ? 4 : 7);
                const int c = 4 * qb + (wave >> 1), qidx = 256 * qb + 32 * wave + q31; const size_t row = (size_t)b * SEQ + qidx;
                f32x16 O1[4]; float l1;
                float* stash = stash_base + (size_t)blockIdx.x * 32768 + tid * 64;
                {
                    attn_core<64, 4, 1, 1, 64>(lds, tid, P + row * PP + 1024 + h * 128, qkg + 128, qkg + 192, P + (size_t)b * SEQ * PP + 1536 + h * 128, PP,
                                           VT + (size_t)32 * 512 * SEQ + (size_t)(b * 512 + h * 128) * SEQ, SEQ, 0, 4 * qb + 4, 0, c, c, qidx, CS + row * 16, CSH + (size_t)b * SEQ * 16, 0, bndB, O1, l1);
                    const float i1 = 1.0f / l1;
#pragma unroll
                    for (int db = 0; db < 4; ++db)
#pragma unroll
                        for (int r4 = 0; r4 < 4; ++r4) *(f32x4*)(stash + db * 16 + 4 * r4) = (f32x4){O1[db][4 * r4] * i1, O1[db][4 * r4 + 1] * i1, O1[db][4 * r4 + 2] * i1, O1[db][4 * r4 + 3] * i1};
                }
                f32x16 O2[4]; float l2;
                attn_core<64, 4, 1, 1, 64>(lds, tid, P + row * PP + 1024 + h * 128 + 64, qkg + 128, qkg + 192, P + (size_t)b * SEQ * PP + 1536 + h * 128 + 64, PP,
                                       VT + (size_t)32 * 512 * SEQ + (size_t)(b * 512 + h * 128) * SEQ, SEQ, 0, 4 * qb + 4, 0, c, c, qidx, CS + row * 16, CSH + (size_t)b * SEQ * 16, 0, bndB, O2, l2);
                const float i2 = lam / l2; float ss = 0.f;
#pragma unroll
                for (int db = 0; db < 4; ++db)
#pragma unroll
                    for (int r4 = 0; r4 < 4; ++r4) { const f32x4 o1 = *(const f32x4*)(stash + db * 16 + 4 * r4);
#pragma unroll
                        for (int j = 0; j < 4; ++j) { const float d = o1[j] - i2 * O2[db][4 * r4 + j]; O2[db][4 * r4 + j] = d; ss += d * d; } }
                ss += __shfl_xor(ss, 32);
                const float rs = rsqrtf(ss * (1.0f / 128.0f) + 1e-6f) * (1.0f - lam_init);
#pragma unroll
                for (int db = 0; db < 4; ++db)
#pragma unroll
                    for (int a = 0; a < 2; ++a) { const float* gp = sub + 32 * db + 16 * a + 8 * hi;
#pragma unroll
                        for (int ee = 0; ee < 8; ++ee) O2[db][8 * a + ee] *= gp[ee]; }
                store_o<4>(OM + row * DM + 512 + h * 128, O2, rs, hi);
            }
        }
    }
}

__device__ __forceinline__ void attn_odd_phase(const Ptrs& I, unsigned char* ws, LAS unsigned char* lds, int tid_in, int layer) {
    int tid = tid_in; asm volatile("" : "+v"(tid));
    using namespace att;
    const int lane = tid & 63, wave = __builtin_amdgcn_readfirstlane(tid >> 6), hi = lane >> 5, q31 = lane & 31, o = layer >> 1;
    const bf16* P = (const bf16*)(ws + WS_P); const bf16* VT = (const bf16*)(ws + WS_VT); bf16* OM = (bf16*)(ws + WS_OMIX);
    const float* qkg_g = I.o_qkg + (size_t)o * 2 * 64;
    LAS float* qkg = (LAS float*)(lds + GOFF);
    if (tid < 128) qkg[tid] = qkg_g[tid];
    __syncthreads();
    for (int v = vcu_index(); v < 256; v += gridDim.x) {
        {
            const float* cw = I.o_conv + (size_t)o * 3 * 512 + lane * 8; float w0[8], w1[8], w2[8];
#pragma unroll
            for (int ee = 0; ee < 8; ++ee) { w0[ee] = cw[ee]; w1[ee] = cw[512 + ee]; w2[ee] = cw[1024 + ee]; }
            for (int rr = wave; rr < 256; rr += NWAVES) {
                const int row = 256 * v + rr, t = row & (SEQ - 1); const bf16* pr = P + (size_t)row * PP + lane * 8;
                float cb[8], u0[8], u1[8], u2[8], a[8], bb[8];
                unpack8(*(const u32x4*)(pr), cb);
                unpack8(*(const u32x4*)(pr + 512), a); unpack8(*(const u32x4*)(pr + 1024), bb);
#pragma unroll
                for (int ee = 0; ee < 8; ++ee) u2[ee] = a[ee] * bb[ee];
                if (t >= 1) { unpack8(*(const u32x4*)(pr - PP + 512), a); unpack8(*(const u32x4*)(pr - PP + 1024), bb);
#pragma unroll
                    for (int ee = 0; ee < 8; ++ee) u1[ee] = a[ee] * bb[ee]; }
                else {
#pragma unroll
                    for (int ee = 0; ee < 8; ++ee) u1[ee] = 0.f; }
                if (t >= 2) { unpack8(*(const u32x4*)(pr - 2 * PP + 512), a); unpack8(*(const u32x4*)(pr - 2 * PP + 1024), bb);
#pragma unroll
                    for (int ee = 0; ee < 8; ++ee) u0[ee] = a[ee] * bb[ee]; }
                else {
#pragma unroll
                    for (int ee = 0; ee < 8; ++ee) u0[ee] = 0.f; }
                float y[8];
#pragma unroll
                for (int ee = 0; ee < 8; ++ee) y[ee] = cb[ee] * (w0[ee] * u0[ee] + w1[ee] * u1[ee] + w2[ee] * u2[ee]);
                *(u32x4*)(OM + (size_t)row * DM + lane * 8) = pack8(y);
            }
        }
        {
            asm volatile("" : "+v"(tid));
            const int b = v >> 3, h = v & 7;
            typedef Cfg<64, 2, 1> C0;
            LAS float* tab = (LAS float*)(lds + C0::XOFF);
            __syncthreads();
            if (tid < 257) tab[tid] = I.o_rel[((size_t)o * 8 + h) * 257 + tid] * LOG2E;
            __syncthreads();
            const bool bnd = 8.0f * att::LOG2E * lds_absmax(qkg, 64, lane) * lds_absmax(qkg + 64, 64, lane) + lds_absmax(tab, 257, lane) < 60.0f;
#pragma unroll 1
            for (int qb = 0; qb < 8; ++qb) {
                const int c = 4 * qb + (wave >> 1), qidx = 256 * qb + 32 * wave + q31; const size_t row = (size_t)b * SEQ + qidx;
                const int kt0 = (4 * qb - 8) > 0 ? (4 * qb - 8) : 0, wlo = (c - 8) > 0 ? (c - 8) : 0;
                f32x16 O[2]; float l;
                attn_core<64, 2, 1, 2, 64>(lds, tid, P + row * PP + 1536 + h * 64, qkg, qkg + 64, P + (size_t)b * SEQ * PP + 2048 + h * 64, PP,
                                       VT + (size_t)(b * 512 + h * 64) * SEQ, SEQ, kt0, 4 * qb + 4, wlo, c, c, qidx, nullptr, nullptr, 0, bnd, O, l);
                store_o<2>(OM + row * DM + 512 + h * 64, O, 1.0f / l, hi);
            }
        }
    }
}

__device__ __forceinline__ void attn_cross_phase(const Ptrs& I, unsigned char* ws, LAS unsigned char* lds, int tid_in, int layer) {
    int tid = tid_in; asm volatile("" : "+v"(tid));
    using namespace att;
    const int lane = tid & 63, wave = __builtin_amdgcn_readfirstlane(tid >> 6), hi = lane >> 5, q31 = lane & 31;
    const bf16* QX = (const bf16*)(ws + WS_QX); const bf16* KX = (const bf16*)(ws + WS_KX); const bf16* VXT = (const bf16*)(ws + WS_VXT); bf16* OX = (bf16*)(ws + WS_OX);
    const float* qkg_g = I.xqkg + (size_t)layer * 2 * 256;
    LAS float* qkg = (LAS float*)(lds + GOFF);
    qkg[tid] = qkg_g[tid];
    __syncthreads();
    const bool bnd = 16.0f * att::LOG2E * lds_absmax(qkg, 256, lane) * lds_absmax(qkg + 256, 256, lane) < 60.0f;
    for (int v = vcu_index(); v < 256; v += gridDim.x) {
        const int pr = v >> 1, b = pr >> 2, h = pr & 3, ds = wave >> 2;
#pragma unroll 1
        for (int qi = 0; qi < 8; ++qi) {
            const int qblk = 8 * (v & 1) + qi, qidx = 128 * qblk + 32 * (wave & 3) + q31; const size_t row = (size_t)b * SEQ + qidx;
            f32x16 O[4]; float l;
            attn_core<256, 4, 2, 3, 32>(lds, tid, QX + row * DM + h * 256, qkg, qkg + 256, KX + (size_t)b * NMEM * DM + h * 256, DM,
                                    VXT + (size_t)(b * 1024 + h * 256) * NMEM, NMEM, 0, 8, 0, 7, 0, qidx, nullptr, nullptr, ds, bnd, O, l);
            store_o<4>(OX + row * DM + h * 256 + ds * 128, O, 1.0f / l, hi);
        }
    }
}

#define XB_TMO      128
#define XB_XCNT(j)  (256  + 64 * (j))
#define XB_XSUB(j)  (1280 + 64 * (j))
#define XB_XGEN(j)  (2304 + 64 * (j))
#define XB_TOP      3328
#define XB_TOPGEN   3392
#define XCD_BAR_WORDS 3456
#define XB_SPIN_CAP (1u << 18)

__device__ __forceinline__ unsigned xb_ld(unsigned* p)              { return __hip_atomic_load(p, __ATOMIC_RELAXED, __HIP_MEMORY_SCOPE_AGENT); }
__device__ __forceinline__ unsigned xb_add(unsigned* p, unsigned v) { return __hip_atomic_fetch_add(p, v, __ATOMIC_RELAXED, __HIP_MEMORY_SCOPE_AGENT); }
__device__ __forceinline__ unsigned xb_xcc_id() { return (unsigned)__builtin_amdgcn_s_getreg((3 << 11) | 20) & 0xFu; }
#define XB_SPIN(cond, bar) do { unsigned _sp = 0; while (cond) { __builtin_amdgcn_s_sleep(1); \
    if ((++_sp & 255u) == 0u) { if (xb_ld(&(bar)[XB_TMO])) break; if (_sp > XB_SPIN_CAP) { atomicAdd(&(bar)[XB_TMO], 1u); break; } } } } while (0)

struct XcdBarrier {
    unsigned* bar; unsigned x;
    volatile LAS unsigned* st;
};

__device__ __forceinline__ XcdBarrier xcd_barrier_post(unsigned* bar, volatile LAS unsigned* st) {
    XcdBarrier b; b.bar = bar; b.x = xb_xcc_id(); b.st = st;
    if (threadIdx.x == 0) (void)xb_add(&bar[XB_XCNT(b.x)], 1u);
    return b;
}
__device__ __forceinline__ void xcd_barrier_complete(unsigned* bar, unsigned x, unsigned& nloc, unsigned& nx) {
    const unsigned G = gridDim.x * gridDim.y * gridDim.z;
    unsigned sum, cnt, mine, sp = 0u;
    for (;;) {
        sum = 0u; cnt = 0u; mine = 0u;
#pragma unroll
        for (unsigned j = 0; j < 16; ++j) { const unsigned c = xb_ld(&bar[XB_XCNT(j)]); sum += c; cnt += (c > 0u) ? 1u : 0u; mine = (j == x) ? c : mine; }
        if (sum == G) break;
        __builtin_amdgcn_s_sleep(1);
        if ((++sp & 255u) == 0u) { if (xb_ld(&bar[XB_TMO])) break; if (sp > XB_SPIN_CAP) { atomicAdd(&bar[XB_TMO], 1u); break; } }
    }
    nloc = mine > 0u ? mine : 1u; nx = cnt > 0u ? cnt : 1u;
}

__device__ __forceinline__ void xcd_barrier(const XcdBarrier& b) {
    asm volatile("s_waitcnt vmcnt(0)" ::: "memory");
    __syncthreads();
    if (threadIdx.x == 0) {
        unsigned* bar = b.bar;
        __builtin_amdgcn_s_waitcnt(0);
        unsigned nloc = b.st[0], nx = b.st[1];
        if (nloc == 0u) { xcd_barrier_complete(bar, b.x, nloc, nx); b.st[0] = nloc; b.st[1] = nx; }
        const unsigned old = xb_add(&bar[XB_XSUB(b.x)], 1u);
        const unsigned gen = old / nloc;
        if (old + 1u == (gen + 1u) * nloc) {
            __builtin_amdgcn_fence(__ATOMIC_RELEASE, "agent");
            asm volatile("s_waitcnt vmcnt(0)" ::: "memory");
            const unsigned og = xb_add(&bar[XB_TOP], 1u);
            const unsigned tg = og / nx;
            if (og + 1u == (tg + 1u) * nx) xb_add(&bar[XB_TOPGEN], 1u);
            else XB_SPIN(xb_ld(&bar[XB_TOPGEN]) == tg, bar);
            __builtin_amdgcn_fence(__ATOMIC_ACQUIRE, "agent");
            xb_add(&bar[XB_XGEN(b.x)], 1u);
            asm volatile("s_waitcnt vmcnt(0)" ::: "memory");
        } else {
            XB_SPIN(xb_ld(&bar[XB_XGEN(b.x)]) == gen, bar);
            __builtin_amdgcn_fence(__ATOMIC_ACQUIRE, "agent");
            asm volatile("s_waitcnt vmcnt(0)" ::: "memory");
        }
    }
    __syncthreads();
}

#define GPTR0(T, v) ((T)(__attribute__((address_space(1))) unsigned char*)(v))
__global__ void __launch_bounds__(NTHREADS, 2) mega_fwd(Args A) {
    extern __shared__ __attribute__((aligned(16))) unsigned char smem[];
    LAS unsigned char* lds = (LAS unsigned char*)smem;
    volatile LAS unsigned* bar_st = (volatile LAS unsigned*)(lds + GOFF + 2048);
    if (threadIdx.x < 2) bar_st[threadIdx.x] = 0u;
    __syncthreads();
    XcdBarrier xbar = xcd_barrier_post((unsigned*)GPTR0(unsigned char*, (unsigned long long)A.ws), bar_st);
    for (int ph = A.ph_lo; ph < A.ph_hi; ++ph) {
        const int tid = threadIdx.x;
#define GPTR(T, v) ((T)(__attribute__((address_space(1))) unsigned char*)(v))
        unsigned long long wsi = (unsigned long long)A.ws; asm volatile("" : "+s"(wsi));
        unsigned char* ws = GPTR(unsigned char*, wsi);
        float* const outp = GPTR(float*, (unsigned long long)A.out);
        const __attribute__((address_space(4))) unsigned char* kp = (const __attribute__((address_space(4))) unsigned char*)__builtin_amdgcn_kernarg_segment_ptr();
        asm volatile("" : "+s"(kp));
#define INP(k) GPTR(const float*, ((const unsigned long long __attribute__((address_space(4)))*)kp)[k])
        Ptrs I;
        I.x = INP(0); I.mem = INP(1); I.pos = (const int*)INP(2); I.ln_g = INP(3); I.f1in = INP(4); I.f1out = INP(5); I.f2in = INP(6); I.f2out = INP(7);
        I.e_win = INP(8); I.e_fb = INP(9); I.e_qkg = INP(10); I.e_lam = INP(11); I.e_sub = INP(12); I.e_wout = INP(13);
        I.o_win = INP(14); I.o_conv = INP(15); I.o_qkg = INP(16); I.o_rel = INP(17); I.o_wout = INP(18);
        I.xwq = INP(19); I.xwkv = INP(20); I.xqkg = INP(21); I.xwo = INP(22);
#undef INP
        float* SSb = (float*)(ws + WS_SS);
        const bf16* XB = nullptr;
        if (ph == 0) {
#ifndef NO_P0
            p0_prologue(I, A, ws, lds, tid, outp);
#endif
        } else {
            const int l = (ph - 1) / 12, kq = (ph - 1) % 12; const bool even = (l & 1) == 0;
            const int k = (kq <= 2) ? kq : (kq == 3) ? 100 : (kq <= 6) ? kq - 1 : (kq == 7) ? 101 : kq - 2;
            unsigned char* wl = ws + WS_W + (size_t)l * W_LAYER;
            XB = (l == DEPTH - 1 && k == 8) ? (const bf16*)(ws + WS_OMIX) : (const bf16*)outp;
            if (k == 0 || k == 8) {
                pg8::Gemm g{XB, (const bf16*)(wl + (k == 0 ? WO_1IN : WO_2IN)), M, 2 * DFF, DM};
                pg8::StaticOrder S; S.init(M, 2 * DFF, (int)gridDim.x, (int)blockIdx.x);
                pg8::EpiSwiglu E{(bf16*)(ws + WS_H), SSb, {{0.f, 0.f, 0.f, 0.f}, {0.f, 0.f, 0.f, 0.f}}, -1};
#ifndef NO_SWIGLU
                pg8::gemm_phase<pg8::EpiSwiglu, pg8::StaticOrder, true, true, true>(lds, g, S, E);
#endif
            } else if (k == 1 || k == 4 || k == 7 || k == 9) {
                const bf16* Aop = (k == 1 || k == 9) ? (const bf16*)(ws + WS_H) : (k == 4) ? (const bf16*)(ws + WS_OMIX) : (const bf16*)(ws + WS_OX);
                const bf16* Bop = (const bf16*)(wl + (k == 1 ? WO_1OUT : k == 9 ? WO_2OUT : k == 4 ? WO_MIXOUT : WO_XO));
                const int Kd = (k == 1 || k == 9) ? DFF : DM;
                pg8::Gemm g{Aop, Bop, M, DM, Kd};
                pg8::StaticOrder S; S.init(M, DM, (int)gridDim.x, (int)blockIdx.x);
                const bool fin = (l == DEPTH - 1 && k == 9), pre = (l == DEPTH - 1 && k == 7);
                pg8::EpiResid E{fin ? (const _Float16*)(ws + WS_OMIX) : (const _Float16*)outp, pre ? (_Float16*)(ws + WS_OMIX) : (_Float16*)outp, nullptr, SSb, A.zero_alpha ? 0.0f : ((k == 1 || k == 9) ? 0.5f : 1.0f), fin ? outp : nullptr};
#ifndef NO_RESID
                pg8::gemm_phase<pg8::EpiResid, pg8::StaticOrder, true, true>(lds, g, S, E);
#endif
            } else if (k == 2 || k == 5) {
                const int nrep = (k == 5) ? 2 : 1;
                for (int rep = 0; rep < nrep; ++rep) {
                    pg8::Gemm g; pg8::EpiProj E; int Md, Nd;
                    if (k == 2) { Md = M; Nd = even ? 3328 : 3072; g = pg8::Gemm{XB, (const bf16*)(wl + WO_MIXIN), Md, Nd, DM};
                        E = pg8::EpiProj{(bf16*)(ws + WS_P), PP, SSb, even ? 9 : 10, (bf16*)(ws + WS_VT), 11, 9, {{0.f, 0.f, 0.f, 0.f}, {0.f, 0.f, 0.f, 0.f}}, -1}; }
                    else if (rep == 0) { Md = M; Nd = DM; g = pg8::Gemm{XB, (const bf16*)(wl + WO_XQ), Md, Nd, DM};
                        E = pg8::EpiProj{(bf16*)(ws + WS_QX), DM, SSb, 4, nullptr, 11, 9, {{0.f, 0.f, 0.f, 0.f}, {0.f, 0.f, 0.f, 0.f}}, -1}; }
                    else { Md = MMEM; Nd = 2 * DM; g = pg8::Gemm{(const bf16*)(ws + WS_MEMB), (const bf16*)(ws + WS_WKV) + (size_t)l * 2048 * DM, Md, Nd, DM};
                        E = pg8::EpiProj{(bf16*)(ws + WS_KX), DM, (const float*)(ws + WS_SSMEM), 4, (bf16*)(ws + WS_VXT), 8, 10, {{0.f, 0.f, 0.f, 0.f}, {0.f, 0.f, 0.f, 0.f}}, -1}; }
                    pg8::StaticOrder S; S.init(Md, Nd, (int)gridDim.x, (int)blockIdx.x);
#ifndef NO_PROJ
                    pg8::gemm_phase<pg8::EpiProj, pg8::StaticOrder, true, true, true>(lds, g, S, E);
#endif
                    __syncthreads();
                }
            } else if (k == 100) {
                kprep_phase(ws, tid, even ? 0 : 1, even ? I.e_qkg + (size_t)(l >> 1) * 256 : I.o_qkg + (size_t)(l >> 1) * 128, nullptr);
            } else if (k == 101) {
                kprep_phase(ws, tid, 2, I.xqkg + (size_t)l * 512, nullptr);
            } else if (k == 3) {
                #ifndef NO_EVEN
                if (even) attn_even_phase(I, ws, lds, tid, l, outp + (size_t)32 * MiB);
#endif
#ifndef NO_ODD
                if (!even) attn_odd_phase(I, ws, lds, tid, l);
#endif
            } else {
#ifndef NO_CROSS
                attn_cross_phase(I, ws, lds, tid, l);
#endif
            }
        }
        if (ph + 1 < A.ph_hi) { if (ph == 0) cg::this_grid().sync(); else xcd_barrier(xbar); }
    }
}

extern "C" void kernel_launch(void* const* d_in, const int* in_sizes, int n_in, void* d_out, int out_size, void* d_ws, size_t ws_size, hipStream_t stream) {
    static int grid = 0;
    if (grid == 0) {
        if (n_in != 23 || out_size != M * DM || ws_size < WS_END) { fprintf(stderr, "kernel_launch: unexpected shapes (n_in %d out %d ws %zu)\n", n_in, out_size, ws_size); grid = -1; return; }
        int dev = 0, cus = 0, per_cu = 0;
        hipGetDevice(&dev); hipDeviceGetAttribute(&cus, hipDeviceAttributeMultiprocessorCount, dev);
        if (hipFuncSetAttribute((const void*)mega_fwd, hipFuncAttributeMaxDynamicSharedMemorySize, LDS_BYTES) != hipSuccess) { fprintf(stderr, "kernel_launch: hipFuncSetAttribute failed\n"); grid = -1; return; }
        if (hipOccupancyMaxActiveBlocksPerMultiprocessor(&per_cu, (const void*)mega_fwd, NTHREADS, LDS_BYTES) != hipSuccess || per_cu < 1) { fprintf(stderr, "kernel_launch: occupancy query says %d\n", per_cu); per_cu = 1; }
        (void)hipGetLastError();
        grid = cus * per_cu; if (grid > 256) grid = 256;
        fprintf(stderr, "kernel_launch: grid %d (cus %d x %d)\n", grid, cus, per_cu);
    }
    if (grid < 0) return;
    (void)hipMemsetAsync(d_ws, 0, 16384, stream);
    Args a{};
    for (int i = 0; i < 23; ++i) a.in[i] = (const float*)d_in[i];
    a.out = (float*)d_out; a.ws = (unsigned char*)d_ws;
    for (int i = 0; i < 8; ++i) a.inv[i] = std::pow(500000.0, -(double)i / 8.0);
    const int NPH = 1 + 12 * DEPTH;
#if MK_SINGLE
    a.ph_lo = 0; a.ph_hi = NPH;
    void* args[] = {&a};
    hipError_t e = hipLaunchCooperativeKernel((const void*)mega_fwd, dim3(grid), dim3(NTHREADS), args, LDS_BYTES, stream);
    if (e != hipSuccess) fprintf(stderr, "cooperative launch failed: %s (grid %d)\n", hipGetErrorString(e), grid);
#else
#ifndef REP_MASK
#define REP_MASK 0
#endif
    for (int ph = 0; ph < NPH; ++ph) { a.ph_lo = ph; a.ph_hi = ph + 1;
        const int kq_ = (ph == 0) ? -1 : (ph - 1) % 12; const int kk = (kq_ < 0) ? -1 : (kq_ <= 2) ? kq_ : (kq_ == 3) ? 100 : (kq_ <= 6) ? kq_ - 1 : (kq_ == 7) ? 101 : kq_ - 2; int nrun = 1;
        if (((REP_MASK & 1) && (kk == 0 || kk == 8)) || ((REP_MASK & 2) && kk == 2) || ((REP_MASK & 4) && kk == 3) || ((REP_MASK & 8) && kk == 5) || ((REP_MASK & 16) && kk == 6) || ((REP_MASK & 32) && ph == 0) || ((REP_MASK & 512) && (kk == 100 || kk == 101)) || ((REP_MASK & 64) && kk == 3 && (((ph - 1) / 12) & 1) == 0) || ((REP_MASK & 128) && kk == 3 && (((ph - 1) / 12) & 1) == 1)) nrun = 2;
        if ((REP_MASK & 256) && (kk == 1 || kk == 4 || kk == 7 || kk == 9)) { a.zero_alpha = 1; hipLaunchKernelGGL(mega_fwd, dim3(grid), dim3(NTHREADS), LDS_BYTES, stream, a); a.zero_alpha = 0; }
        for (int r = 0; r < nrun; ++r) hipLaunchKernelGGL(mega_fwd, dim3(grid), dim3(NTHREADS), LDS_BYTES, stream, a); }
#endif
}
```

```cpp
#include <hip/hip_runtime.h>
#include <hip/hip_cooperative_groups.h>
#include <cstdio>
#include <cstdint>
#include <cmath>
#define MK_SINGLE 1
namespace pg8 {
#define PG8_LAS __attribute__((address_space(3)))
typedef unsigned short bf16_t;
typedef short bf16x8 __attribute__((ext_vector_type(8)));
typedef float f32x4 __attribute__((ext_vector_type(4)));
typedef unsigned u32x4 __attribute__((ext_vector_type(4)));
constexpr int BM = 256, BK = 64, HALF = 128, HTB = HALF * BK * 2  , STAGE_BYTES = 8 * HTB, NXCD = 8, WGM = 8;

__host__ __device__ __forceinline__ int lds_byte(int r, int c) { const int st = (r >> 4) * 2 + (c >> 5), rr = r & 15, cc = c & 31, ob = rr * 64 + cc * 2; return st * 1024 + (ob ^ (((ob >> 9) & 1) << 5)); }
__host__ __device__ __forceinline__ void stage_rc(int b, int& R, int& C) { const int st = b / 1024, sb = b % 1024, swz = sb ^ (((sb >> 9) & 1) << 5); R = (st >> 1) * 16 + swz / 64; C = (st & 1) * 32 + (swz % 64) / 2; }
__host__ __device__ __forceinline__ int perm32(int rho) { const int n = rho >> 4, i = rho & 15; return 8 * (i >> 2) + 4 * n + (i & 3); }

struct Unit { int pm, pn; };
struct Gemm { const bf16_t* A; const bf16_t* Bt; int M, N, K; };

struct StaticOrder {
    int nM, nN, nwg, G, c;
    __host__ __device__ void init(int M, int N, int G_, int c_) { nM = M / BM; nN = N / BM; nwg = nM * nN; G = G_; c = c_; }
    __host__ __device__ bool next(int i, Unit& u) const {
        const long L = (long)i * G + c; if (L >= nwg) return false;
        int wgid = (int)L; { const int q = nwg / NXCD, r = nwg % NXCD, xcd = wgid % NXCD, off = wgid / NXCD; wgid = (xcd < r ? xcd * (q + 1) : r * (q + 1) + (xcd - r) * q) + off; }
        const int nig = WGM * nN, gid = wgid / nig, fm = gid * WGM, gsz = (nM - fm) < WGM ? (nM - fm) : WGM;
        u.pm = fm + ((wgid % nig) % gsz); u.pn = (wgid % nig) / gsz; return true;
    }
    __device__ __forceinline__ void a_ready(const Unit&) const {}
    __device__ __forceinline__ void done(const Unit&) const {}
};

__device__ __forceinline__ unsigned cvt_pk_bf16(float lo, float hi) { unsigned r; asm volatile("v_cvt_pk_bf16_f32 %0, %1, %2" : "=v"(r) : "v"(lo), "v"(hi)); return r; }
typedef float f32x2 __attribute__((ext_vector_type(2)));

typedef unsigned u32x2 __attribute__((ext_vector_type(2)));
typedef _Float16 f16x8v __attribute__((ext_vector_type(8)));
__device__ __forceinline__ float bf2f(unsigned v) { return __uint_as_float(v << 16); }
__device__ __forceinline__ float row_rs(const float* SSP, int row) {
    const f32x4* p = (const f32x4*)(SSP + (size_t)row * 16); const f32x4 a = p[0], b = p[1], c = p[2], d = p[3];
    const float s = (((a[0] + a[1]) + (a[2] + a[3])) + ((b[0] + b[1]) + (b[2] + b[3]))) + (((c[0] + c[1]) + (c[2] + c[3])) + ((d[0] + d[1]) + (d[2] + d[3])));
    return rsqrtf(s * (1.0f / 1024.0f) + 1e-6f);
}

struct EpiSwiglu {
    static constexpr bool PERM = true, AFTER_DRAIN = false;
    bf16_t* H; const float* SS;
    mutable float rsv[2][4]; mutable int last_pm;
    __device__ __forceinline__ void operator()(const f32x4 (&acc)[2][2][4][2], const Unit& u, int wr, int wc, int fr, int fq) const {
        const int row0 = u.pm * BM + wr * 64 + fr; const int col0 = u.pn * 128 + wc * 32 + 8 * fq;
        if (u.pm != last_pm) {
            last_pm = u.pm;
#pragma unroll
            for (int ai = 0; ai < 2; ++ai)
#pragma unroll
                for (int m = 0; m < 4; ++m) rsv[ai][m] = row_rs(SS, row0 + ai * HALF + m * 16);
        }
#pragma unroll
        for (int ai = 0; ai < 2; ++ai)
#pragma unroll
            for (int m = 0; m < 4; ++m) {
                const int row = row0 + ai * HALF + m * 16;
                const float rs = rsv[ai][m];
                unsigned w[4];
#pragma unroll
                for (int n = 0; n < 2; ++n) {
                    const f32x4 g = acc[ai][0][m][n] * rs, uu = acc[ai][1][m][n] * rs; float hv[4];
#pragma unroll
                    for (int j = 0; j < 4; ++j) { const float e = __expf(-g[j]); hv[j] = g[j] * __builtin_amdgcn_rcpf(1.0f + e) * uu[j]; }
                    w[2 * n] = cvt_pk_bf16(hv[0], hv[1]); w[2 * n + 1] = cvt_pk_bf16(hv[2], hv[3]);
                }
                *(u32x4*)(H + (size_t)row * 2816 + col0) = (u32x4){w[0], w[1], w[2], w[3]};
            }
    }
};

typedef _Float16 f16x4 __attribute__((ext_vector_type(4)));
typedef _Float16 f16x8 __attribute__((ext_vector_type(8)));
struct EpiResid {
    static constexpr bool PERM = true, AFTER_DRAIN = false;
    const _Float16* xin; _Float16* xout; bf16_t* XB; float* SSn; float alpha; float* outf;
    __device__ __forceinline__ void operator()(const f32x4 (&acc)[2][2][4][2], const Unit& u, int wr, int wc, int fr, int fq) const {
        const int row0 = u.pm * BM + wr * 64 + fr; const int col0 = u.pn * BM + wc * 32 + 8 * fq;
        f16x8 xhv[2][4][2];
#pragma unroll
        for (int ai = 0; ai < 2; ++ai)
#pragma unroll
            for (int m = 0; m < 4; ++m)
#pragma unroll
                for (int bj = 0; bj < 2; ++bj) xhv[ai][m][bj] = *(const f16x8*)(xin + (size_t)(row0 + ai * HALF + m * 16) * 1024 + col0 + bj * HALF);
#pragma unroll
        for (int ai = 0; ai < 2; ++ai) {
#pragma unroll
            for (int m = 0; m < 4; ++m) {
                const int row = row0 + ai * HALF + m * 16; const size_t off = (size_t)row * 1024 + col0; float ss = 0.f;
#pragma unroll
                for (int bj = 0; bj < 2; ++bj) {
                    const size_t o = off + bj * HALF;
                    const f16x8 xh = xhv[ai][m][bj];
                    const f32x4 x0 = (f32x4){(float)xh[0], (float)xh[1], (float)xh[2], (float)xh[3]} + acc[ai][bj][m][0] * alpha;
                    const f32x4 x1 = (f32x4){(float)xh[4], (float)xh[5], (float)xh[6], (float)xh[7]} + acc[ai][bj][m][1] * alpha;
                    if (outf) { *(f32x4*)(outf + o) = x0; *(f32x4*)(outf + o + 4) = x1; }
                    else {
                        *(f16x8*)(xout + o) = (f16x8){(_Float16)x0[0], (_Float16)x0[1], (_Float16)x0[2], (_Float16)x0[3], (_Float16)x1[0], (_Float16)x1[1], (_Float16)x1[2], (_Float16)x1[3]};
                        ss += ((x0[0] * x0[0] + x0[1] * x0[1]) + (x0[2] * x0[2] + x0[3] * x0[3])) + ((x1[0] * x1[0] + x1[1] * x1[1]) + (x1[2] * x1[2] + x1[3] * x1[3]));
                    }
                }
                if (!outf) { ss += __shfl_xor(ss, 16); ss += __shfl_xor(ss, 32);
                    if (fq == 0) SSn[(size_t)row * 16 + u.pn * 4 + wc] = ss; }
            }
        }
    }
};

struct EpiProj {
    static constexpr bool PERM = true, AFTER_DRAIN = false;
    bf16_t* P; int ldp; const float* SS; int nP; bf16_t* VT; int tsh; int cwsh;
    mutable float rsv[2][4]; mutable int last_pm;
    __device__ __forceinline__ void operator()(const f32x4 (&acc)[2][2][4][2], const Unit& u, int wr, int wc, int fr, int fq) const {
        const int row0 = u.pm * BM + wr * 64 + fr;
        if (u.pm != last_pm) {
            last_pm = u.pm;
#pragma unroll
            for (int ai = 0; ai < 2; ++ai)
#pragma unroll
                for (int m = 0; m < 4; ++m) rsv[ai][m] = row_rs(SS, row0 + ai * HALF + m * 16);
        }
        if (u.pn < nP) {
            const int col0 = u.pn * BM + wc * 32 + 8 * fq;
#pragma unroll
            for (int ai = 0; ai < 2; ++ai)
#pragma unroll
                for (int m = 0; m < 4; ++m) {
                    const int row = row0 + ai * HALF + m * 16;
                    const float rs = rsv[ai][m];
                    bf16_t* rowp = P + (size_t)row * ldp + col0;
#pragma unroll
                    for (int bj = 0; bj < 2; ++bj) {
                        const f32x4 v0 = acc[ai][bj][m][0] * rs, v1 = acc[ai][bj][m][1] * rs;
                        u32x4 w; w.x = cvt_pk_bf16(v0[0], v0[1]); w.y = cvt_pk_bf16(v0[2], v0[3]); w.z = cvt_pk_bf16(v1[0], v1[1]); w.w = cvt_pk_bf16(v1[2], v1[3]);
                        *(u32x4*)(rowp + bj * HALF) = w;
                    }
                }
        } else {
            const int T = 1 << tsh, CWm = (1 << cwsh) - 1;
            const int ccb = (u.pn - nP) * BM + wc * 32 + 8 * fq;
#pragma unroll
            for (int ai = 0; ai < 2; ++ai)
#pragma unroll
                for (int m = 0; m < 4; ++m) {
                    const int row = row0 + ai * HALF + m * 16;
                    const float rs = rsv[ai][m];
                    const int b = row >> tsh, t = row & (T - 1);
                    const int odd = fr & 1, te = t & ~1;
#pragma unroll
                    for (int bj = 0; bj < 2; ++bj)
#pragma unroll
                        for (int n = 0; n < 2; ++n)
#pragma unroll
                            for (int jp = 0; jp < 2; ++jp) {
                                const float va = acc[ai][bj][m][n][2 * jp] * rs, vb = acc[ai][bj][m][n][2 * jp + 1] * rs;
                                const float give = odd ? va : vb;
                                const float got = __builtin_bit_cast(float, __builtin_amdgcn_update_dpp(0, __builtin_bit_cast(int, give), 0xB1, 0xF, 0xF, true));
                                const int j = 2 * jp + odd;
                                const unsigned w = odd ? cvt_pk_bf16(got, vb) : cvt_pk_bf16(va, got);
                                const int cc = ccb + bj * HALF + 4 * n + j;
                                const size_t o = ((size_t)((((cc >> cwsh) * 32 + b) << cwsh) + (cc & CWm)) << tsh) + te;
                                *(unsigned*)(VT + o) = w;
                            }
                }
        }
    }
};
template <class Epi, class Sched, bool ALIGN_EPI = false, bool SP2 = false, bool F16 = false>
__device__ __forceinline__ void gemm_phase(PG8_LAS unsigned char* lds, const Gemm g, const Sched& S, const Epi& E) {
    int tid_raw_ = threadIdx.x; asm volatile("" : "+v"(tid_raw_));
    const int tid = tid_raw_, wid = __builtin_amdgcn_readfirstlane(tid >> 6), lane = tid & 63, wr = wid >> 2, wc = wid & 3, fr = lane & 15, fq = lane >> 4;
    const int K = g.K, nt = K / BK;
    unsigned voffA[2], voffB[2];
#pragma unroll
    for (int i = 0; i < 2; ++i) { int R, C; stage_rc(tid * 16 + i * 8192, R, C); const int Rb = Epi::PERM ? ((R & ~31) + perm32(R & 31)) : R;
        voffA[i] = (unsigned)(R * K + C) * 2u; voffB[i] = (unsigned)(Rb * K + C) * 2u; }
    const size_t kstep = (size_t)(BK * 2);
    const size_t hstep = (size_t)HALF * K * 2;
    const size_t tstep = 2 * hstep;
    const unsigned ldsw = (unsigned)wid * 1024u;
    const int aoff = lds_byte(wr * 64 + fr, fq * 8), boff = lds_byte(wc * 32 + fr, fq * 8);
#define PG8_SA(b, h) (((b) * 2 + (h)) * HTB)
#define PG8_SB(b, h) ((4 + (b) * 2 + (h)) * HTB)
#define PG8_STAGE(bufoff, gbase, voff) do { _Pragma("unroll") for (int _i = 0; _i < 2; ++_i) \
        __builtin_amdgcn_global_load_lds((const unsigned*)((const char*)(gbase) + (voff)[_i]), (PG8_LAS unsigned*)(lds + (bufoff) + ldsw + _i * 8192), 16, 0, 0); } while (0)
#define PG8_LDA(dst, b, h) do { _Pragma("unroll") for (int m = 0; m < 4; ++m) _Pragma("unroll") for (int k = 0; k < 2; ++k) dst[m][k] = *(const PG8_LAS bf16x8*)(lds + PG8_SA(b, h) + aoff + m * 2048 + k * 1024); } while (0)
#define PG8_LDB(dst, b, h) do { _Pragma("unroll") for (int n = 0; n < 2; ++n) _Pragma("unroll") for (int k = 0; k < 2; ++k) dst[n][k] = *(const PG8_LAS bf16x8*)(lds + PG8_SB(b, h) + boff + n * 2048 + k * 1024); } while (0)
#define PG8_MMA(ai, bj, At, Bt) do { __builtin_amdgcn_s_setprio(1); _Pragma("unroll") for (int m = 0; m < 4; ++m) _Pragma("unroll") for (int n = 0; n < 2; ++n) _Pragma("unroll") for (int k = 0; k < 2; ++k) \
        acc[ai][bj][m][n] = F16 ? __builtin_amdgcn_mfma_f32_16x16x32_f16(__builtin_bit_cast(f16x8v, Bt[n][k]), __builtin_bit_cast(f16x8v, At[m][k]), acc[ai][bj][m][n], 0, 0, 0) : __builtin_amdgcn_mfma_f32_16x16x32_bf16(Bt[n][k], At[m][k], acc[ai][bj][m][n], 0, 0, 0); __builtin_amdgcn_s_setprio(0); } while (0)
#define PG8_WAIT_V(n) asm volatile("s_waitcnt vmcnt(" #n ")" ::: "memory")
#define PG8_WAIT_L(n) asm volatile("s_waitcnt lgkmcnt(" #n ")" ::: "memory")
#define PG8_BAR __builtin_amdgcn_s_barrier()
#define PG8_SCHED __builtin_amdgcn_sched_barrier(0)
    Unit cur, nxt; int ui = 0;
    if (!S.next(0, cur)) return;
    f32x4 acc[2][2][4][2];
#pragma unroll
    for (int a = 0; a < 2; ++a)
#pragma unroll
        for (int b = 0; b < 2; ++b)
#pragma unroll
            for (int m = 0; m < 4; ++m)
#pragma unroll
                for (int n = 0; n < 2; ++n) acc[a][b][m][n] = (f32x4){0.f, 0.f, 0.f, 0.f};
    bf16x8 At[4][2], B0[2][2], B1[2][2];
    const char* cA = (const char*)g.A + (size_t)cur.pm * tstep; const char* cB = (const char*)g.Bt + (size_t)cur.pn * tstep;
    S.a_ready(cur);
    if constexpr (SP2) {
        PG8_STAGE(PG8_SB(0, 0), cB, voffB); PG8_STAGE(PG8_SB(0, 1), cB + hstep, voffB); PG8_STAGE(PG8_SA(0, 0), cA, voffA); PG8_STAGE(PG8_SA(0, 1), cA + hstep, voffA);
        if (wr == 1) PG8_BAR;
        PG8_WAIT_V(2); PG8_BAR;
        PG8_STAGE(PG8_SB(1, 0), cB + kstep, voffB); PG8_STAGE(PG8_SA(1, 0), cA + kstep, voffA); PG8_STAGE(PG8_SB(1, 1), cB + hstep + kstep, voffB);
        PG8_WAIT_V(6); PG8_BAR;
    } else {
        PG8_STAGE(PG8_SB(0, 0), cB, voffB); PG8_STAGE(PG8_SA(0, 0), cA, voffA); PG8_STAGE(PG8_SB(0, 1), cB + hstep, voffB); PG8_STAGE(PG8_SA(0, 1), cA + hstep, voffA);
        if (wr == 1) PG8_BAR;
        PG8_WAIT_V(4); PG8_BAR;
        PG8_STAGE(PG8_SB(1, 0), cB + kstep, voffB); PG8_STAGE(PG8_SA(1, 0), cA + kstep, voffA); PG8_STAGE(PG8_SB(1, 1), cB + hstep + kstep, voffB);
        PG8_WAIT_V(6); PG8_BAR;
    }
    for (;;) {
        const bool has_next = S.next(ui + 1, nxt);
        const char* nA = has_next ? (const char*)g.A + (size_t)nxt.pm * tstep : cA; const char* nB = has_next ? (const char*)g.Bt + (size_t)nxt.pn * tstep : cB;
        for (int t = 0; t < nt; t += 2) {
            const bool last = (t == nt - 2);
            const char* a1 = cA + (size_t)(t + 1) * kstep;
            const char* a2 = last ? nA : cA + (size_t)(t + 2) * kstep; const char* b2 = last ? nB : cB + (size_t)(t + 2) * kstep;
            const char* a3 = a2 + kstep; const char* b3 = b2 + kstep;
            if (last && has_next) S.a_ready(nxt);
            if constexpr (SP2) {
            PG8_LDB(B0, 0, 0); PG8_LDB(B1, 0, 1); PG8_SCHED; PG8_LDA(At, 0, 0); PG8_STAGE(PG8_SA(1, 1), a1 + hstep, voffA);
            PG8_WAIT_V(8); PG8_WAIT_L(0); PG8_BAR; PG8_MMA(0, 0, At, B0); PG8_MMA(0, 1, At, B1); PG8_BAR; PG8_SCHED;
            PG8_LDA(At, 0, 1); PG8_STAGE(PG8_SB(0, 0), b2, voffB); PG8_STAGE(PG8_SB(0, 1), b2 + hstep, voffB); PG8_STAGE(PG8_SA(0, 0), a2, voffA);
            PG8_WAIT_V(8); PG8_WAIT_L(0); PG8_BAR; PG8_MMA(1, 0, At, B0); PG8_MMA(1, 1, At, B1); PG8_BAR; PG8_SCHED;
            PG8_LDB(B0, 1, 0); PG8_LDB(B1, 1, 1); PG8_SCHED; PG8_LDA(At, 1, 0); PG8_STAGE(PG8_SA(0, 1), a2 + hstep, voffA);
            PG8_WAIT_V(8); PG8_WAIT_L(0); PG8_BAR; PG8_MMA(0, 0, At, B0); PG8_MMA(0, 1, At, B1); PG8_BAR; PG8_SCHED;
            PG8_LDA(At, 1, 1); PG8_STAGE(PG8_SB(1, 0), b3, voffB); PG8_STAGE(PG8_SB(1, 1), b3 + hstep, voffB); PG8_STAGE(PG8_SA(1, 0), a3, voffA);
            PG8_WAIT_V(8); PG8_WAIT_L(0); PG8_BAR; PG8_MMA(1, 0, At, B0); PG8_MMA(1, 1, At, B1); PG8_BAR; PG8_SCHED;
            } else {
            PG8_LDB(B0, 0, 0); PG8_SCHED; PG8_LDA(At, 0, 0); PG8_STAGE(PG8_SA(1, 1), a1 + hstep, voffA);
            PG8_WAIT_L(8); PG8_BAR; PG8_WAIT_L(0); PG8_MMA(0, 0, At, B0); PG8_BAR; PG8_SCHED;
            PG8_LDB(B1, 0, 1); PG8_STAGE(PG8_SB(0, 0), b2, voffB);
            PG8_BAR; PG8_WAIT_L(0); PG8_MMA(0, 1, At, B1); PG8_BAR;
            PG8_LDA(At, 0, 1); PG8_STAGE(PG8_SA(0, 0), a2, voffA);
            PG8_BAR; PG8_WAIT_L(0); PG8_MMA(1, 0, At, B0); PG8_BAR; PG8_SCHED;
            PG8_STAGE(PG8_SB(0, 1), b2 + hstep, voffB);
            PG8_WAIT_V(6); PG8_BAR; PG8_MMA(1, 1, At, B1); PG8_BAR;
            PG8_LDB(B0, 1, 0); PG8_SCHED; PG8_LDA(At, 1, 0); PG8_STAGE(PG8_SA(0, 1), a2 + hstep, voffA);
            PG8_WAIT_L(8); PG8_BAR; PG8_WAIT_L(0); PG8_MMA(0, 0, At, B0); PG8_BAR; PG8_SCHED;
            PG8_LDB(B1, 1, 1); PG8_STAGE(PG8_SB(1, 0), b3, voffB);
            PG8_BAR; PG8_WAIT_L(0); PG8_MMA(0, 1, At, B1); PG8_BAR;
            PG8_LDA(At, 1, 1); PG8_STAGE(PG8_SA(1, 0), a3, voffA);
            PG8_BAR; PG8_WAIT_L(0); PG8_MMA(1, 0, At, B0); PG8_BAR; PG8_SCHED;
            PG8_STAGE(PG8_SB(1, 1), b3 + hstep, voffB);
            PG8_WAIT_V(6); PG8_BAR; PG8_MMA(1, 1, At, B1); PG8_BAR;
            }
        }
        if constexpr (ALIGN_EPI) { if (wr == 0) PG8_BAR; }
        if constexpr (!Epi::AFTER_DRAIN) { E(acc, cur, wr, wc, fr, fq); S.done(cur); }
        if (!has_next) break;
#pragma unroll
        for (int a = 0; a < 2; ++a)
#pragma unroll
            for (int b = 0; b < 2; ++b)
#pragma unroll
                for (int m = 0; m < 4; ++m)
#pragma unroll
                    for (int n = 0; n < 2; ++n) acc[a][b][m][n] = (f32x4){0.f, 0.f, 0.f, 0.f};
        cur = nxt; cA = nA; cB = nB; ++ui;
        if constexpr (ALIGN_EPI) { if (wr == 1) PG8_BAR; }
    }
    PG8_WAIT_V(0);
    if constexpr (!ALIGN_EPI) { if (wr == 0) PG8_BAR; }
    PG8_BAR;
    if constexpr (Epi::AFTER_DRAIN) { E.fused(acc, cur, wr, wc, fr, fq, lds, wid, lane); S.done(cur); }
#undef PG8_SA
#undef PG8_SB
#undef PG8_STAGE
#undef PG8_LDA
#undef PG8_LDB
#undef PG8_MMA
#undef PG8_WAIT_V
#undef PG8_WAIT_L
#undef PG8_BAR
#undef PG8_SCHED
}
}

namespace att {
#define LAS __attribute__((address_space(3)))
typedef unsigned short bf16_t;
typedef short bf16x8 __attribute__((ext_vector_type(8)));
typedef float f32x16 __attribute__((ext_vector_type(16)));
typedef float f32x4 __attribute__((ext_vector_type(4)));
typedef unsigned u32x4 __attribute__((ext_vector_type(4)));
typedef _Float16 f16x8 __attribute__((ext_vector_type(8)));
constexpr float LOG2E = 1.4426950408889634f;
constexpr float NEG_BIG = -1.0e30f;
__device__ __forceinline__ int pi32(int m) { return (m & 0x13) | ((m & 4) << 1) | ((m & 8) >> 1); }
__device__ __forceinline__ unsigned cvtpk(float lo, float hi) { unsigned r; asm volatile("v_cvt_pk_bf16_f32 %0, %1, %2" : "=v"(r) : "v"(lo), "v"(hi)); return r; }
__device__ __forceinline__ float bflo(unsigned w) { return __uint_as_float(w << 16); }
__device__ __forceinline__ float bfhi(unsigned w) { return __uint_as_float(w & 0xffff0000u); }
__device__ __forceinline__ void unpack8(const u32x4 r, float (&x)[8]) {
    x[0] = bflo(r.x); x[1] = bfhi(r.x); x[2] = bflo(r.y); x[3] = bfhi(r.y); x[4] = bflo(r.z); x[5] = bfhi(r.z); x[6] = bflo(r.w); x[7] = bfhi(r.w);
}
__device__ __forceinline__ u32x4 pack8(const float (&x)[8]) { u32x4 w; w.x = cvtpk(x[0], x[1]); w.y = cvtpk(x[2], x[3]); w.z = cvtpk(x[4], x[5]); w.w = cvtpk(x[6], x[7]); return w; }

template <int DK, int NDB, int NSPLIT, int TK = 64> struct Cfg {
    static constexpr int NPB = (NDB == 2) ? 2 : 1;
    static constexpr int KS = DK * 2 + 16, KBUF = TK * KS, DVT = 32 * NDB * NSPLIT, VSB = TK * 2 + 16, VBUF = DVT * VSB, XOFF = 2 * NPB * (KBUF + VBUF);
    static constexpr int PPR = DK / 8, RPI = 512 / PPR, NKL = TK / RPI;
    static constexpr int PV = TK / 8, RVI = 512 / PV, NVL = DVT / RVI;
    static constexpr int NSB = TK / 32, NKS = TK / 16;
};

template <int DK, int NDB, int NSPLIT, int MODE, int TK>
__device__ __forceinline__ void attn_core(LAS unsigned char* lds, const int tid,
        const bf16_t* Qrow, const LAS float* gq, const LAS float* gk,
        const bf16_t* Kbase, const int kpitch, const bf16_t* VTbase, const int vtpitch,
        const int kt0, const int kt1, const int wlo, const int whi, const int diag,
        const int qidx, const float* CSq, const _Float16* CSk, const int dsplit, const bool bounded,
        f32x16 (&O)[NDB], float& lsum_out) {
    typedef Cfg<DK, NDB, NSPLIT, TK> C;
    const int lane = tid & 63, hi = lane >> 5, q31 = lane & 31, pim = pi32(q31);
    bf16x8 qf[DK / 16];
#define ATT_QPROLOGUE() do { \
        u32x4 qraw_[DK / 16]; \
        _Pragma("unroll") for (int d0 = 0; d0 < DK / 16; ++d0) qraw_[d0] = *(const u32x4*)(Qrow + 16 * d0 + 8 * hi); \
        f32x4 cq_[4]; \
        if (MODE == 1) { _Pragma("unroll") for (int i_ = 0; i_ < 4; ++i_) cq_[i_] = *(const f32x4*)(CSq + 4 * i_); } \
        float ss = 0.f; \
        _Pragma("unroll") for (int d0 = 0; d0 < DK / 16; ++d0) { float x[8]; unpack8(qraw_[d0], x); \
            _Pragma("unroll") for (int e = 0; e < 8; ++e) ss += x[e] * x[e]; } \
        ss += __shfl_xor(ss, 32); \
        const float rs = rsqrtf(ss * (1.0f / DK) + 1e-6f) * (rsqrtf((float)DK) * LOG2E); \
        _Pragma("unroll") for (int d0 = 0; d0 < DK / 16; ++d0) { float x[8]; unpack8(qraw_[d0], x); \
            const f32x4 g0 = *(const LAS f32x4*)(gq + 16 * d0 + 8 * hi), g1 = *(const LAS f32x4*)(gq + 16 * d0 + 8 * hi + 4); \
            _Pragma("unroll") for (int e = 0; e < 4; ++e) { x[e] *= rs * g0[e]; x[4 + e] *= rs * g1[e]; } \
            if (MODE == 1 && d0 == 0) { \
                _Pragma("unroll") for (int e = 0; e < 8; ++e) { const float xp = __shfl_xor(x[e], 32); const float c = cq_[e >> 2][e & 3], sn = cq_[2 + (e >> 2)][e & 3]; x[e] = hi ? (x[e] * c + xp * sn) : (x[e] * c - xp * sn); } \
            } \
            const u32x4 w = pack8(x); qf[d0] = __builtin_bit_cast(bf16x8, w); } \
    } while (0)
    const int kpiece = tid % C::PPR, krow = tid / C::PPR, vpiece = tid % C::PV, vrow = tid / C::PV;
    const unsigned koff = (unsigned)(krow * kpitch * 2 + kpiece * 16), voff = (unsigned)(vrow * vtpitch * 2 + vpiece * 16);
    const unsigned klds = (unsigned)(krow * C::KS + kpiece * 16), vlds = (unsigned)(2 * C::NPB * C::KBUF + vrow * C::VSB + vpiece * 16);
    constexpr bool DEEP = (C::NPB == 2);
    constexpr int NP = DEEP ? 2 : 1;
    constexpr int PVB = (NDB <= 2) ? 2 : 1, KFB = (MODE == 1) ? 2 : ((MODE == 3) ? 8 : 4);
    u32x4 kr[NP][C::NKL], vr[NP][C::NVL];
#define ATT_GLD(dst, ptr) do { dst = *(const u32x4*)(ptr); } while (0)
#define ATT_LOAD(st, kt) do { \
    _Pragma("unroll") for (int i_ = 0; i_ < C::NKL; ++i_) { const char* kbp_ = (const char*)(Kbase + (size_t)((kt) * TK + i_ * C::RPI) * kpitch); ATT_GLD(kr[st][i_], kbp_ + koff); } \
    _Pragma("unroll") for (int i_ = 0; i_ < C::NVL; ++i_) { const char* vbp_ = (const char*)(VTbase + (size_t)(i_ * C::RVI) * vtpitch + (kt) * TK); ATT_GLD(vr[st][i_], vbp_ + voff); } } while (0)
#define ATT_WAIT(st, newer) do { } while (0)
#define ATT_STORE(st, kt, buf) do { \
    _Pragma("unroll") for (int i_ = 0; i_ < C::NKL; ++i_) { *(LAS u32x4*)(lds + (buf) * C::KBUF + i_ * C::RPI * C::KS + klds) = kr[st][i_]; } \
    _Pragma("unroll") for (int i_ = 0; i_ < C::NVL; ++i_) { *(LAS u32x4*)(lds + (buf) * C::VBUF + i_ * C::RVI * C::VSB + vlds) = vr[st][i_]; } } while (0)

#pragma unroll
    for (int db = 0; db < NDB; ++db)
#pragma unroll
        for (int r = 0; r < 16; ++r) O[db][r] = 0.f;
    constexpr float THR = 16.0f;
    constexpr bool LMFMA = (NDB <= 2);
    float lsum = 0.f;
    f32x16 lacc;
    if (LMFMA) {
#pragma unroll
        for (int r = 0; r < 16; ++r) lacc[r] = 0.f;
    }
    const bf16x8 onesf = {(short)0x3F80, (short)0x3F80, (short)0x3F80, (short)0x3F80, (short)0x3F80, (short)0x3F80, (short)0x3F80, (short)0x3F80};
    float Fq = 0.f;
    if (MODE == 0) Fq = ((const LAS float*)(lds + C::XOFF))[qidx];
    f32x16 cinit;
    float moff = 0.f;
    if (MODE == 0) {
#pragma unroll
        for (int r = 0; r < 16; ++r) cinit[r] = Fq;
    }
    ATT_LOAD(0, kt0);
    if (DEEP) ATT_LOAD(1, kt0 + 1);
    ATT_QPROLOGUE();
    ATT_STORE(0, kt0, 0);
    if (DEEP) ATT_STORE(1, kt0 + 1, 1);
    __syncthreads();
    int cur = 0;
#pragma unroll 1
    for (int kt2 = kt0; kt2 < kt1; kt2 += NP) {
#pragma unroll
      for (int p = 0; p < NP; ++p) {
        const int kt = kt2 + p;
        if (kt < kt1) {
        const bool more = DEEP ? (kt2 + 2 < kt1) : (kt + 1 < kt1);
        if (DEEP && p == 0 && more) { ATT_LOAD(0, kt2 + 2); ATT_LOAD(1, kt2 + 3); }
        if (MODE == 1 && more) ATT_LOAD(0, kt + 1);
        if (kt >= wlo && kt <= whi) {
            const LAS unsigned char* kb = lds + (cur * NP + p) * C::KBUF + pim * C::KS + hi * 16;
            f32x16 s[C::NSB];
#pragma unroll
            for (int dg = 0; dg < DK / (16 * KFB); ++dg) {
                bf16x8 kf[C::NSB][KFB];
#pragma unroll
                for (int dd = 0; dd < KFB; ++dd)
#pragma unroll
                    for (int sb = 0; sb < C::NSB; ++sb) kf[sb][dd] = *(const LAS bf16x8*)(kb + sb * 32 * C::KS + (dg * KFB + dd) * 32);
                __builtin_amdgcn_sched_barrier(0);
#pragma unroll
                for (int dd = 0; dd < KFB; ++dd)
#pragma unroll
                    for (int sb = 0; sb < C::NSB; ++sb) {
                        const int d0 = dg * KFB + dd;
                        if (d0 == 0) { if (MODE == 0) s[sb] = __builtin_amdgcn_mfma_f32_32x32x16_bf16(kf[sb][dd], qf[d0], cinit, 0, 0, 0);
                                       else { f32x16 z;
#pragma unroll
                                              for (int r = 0; r < 16; ++r) z[r] = 0.f;
                                              s[sb] = __builtin_amdgcn_mfma_f32_32x32x16_bf16(kf[sb][dd], qf[d0], z, 0, 0, 0); } }
                        else s[sb] = __builtin_amdgcn_mfma_f32_32x32x16_bf16(kf[sb][dd], qf[d0], s[sb], 0, 0, 0);
                    }
                __builtin_amdgcn_sched_barrier(0);
            }
            if (MODE == 3 && more) { ATT_LOAD(0, kt + 1); __builtin_amdgcn_sched_barrier(0); }
            if (MODE == 0) {
                const LAS float* Fl = (const LAS float*)(lds + C::XOFF);
                const int kb0 = kt * TK + 8 * hi;
#pragma unroll
                for (int sb = 0; sb < C::NSB; ++sb)
#pragma unroll
                    for (int a = 0; a < 2; ++a) {
                        const f32x4 f0 = *(const LAS f32x4*)(Fl + kb0 + 32 * sb + 16 * a), f1 = *(const LAS f32x4*)(Fl + kb0 + 32 * sb + 16 * a + 4);
#pragma unroll
                        for (int e = 0; e < 4; ++e) { s[sb][8 * a + e] -= f0[e]; s[sb][8 * a + 4 + e] -= f1[e]; }
                    }
                if (kt == diag) {
#pragma unroll
                    for (int sb = 0; sb < C::NSB; ++sb)
#pragma unroll
                        for (int r = 0; r < 16; ++r) { const int key = kb0 + 32 * sb + 16 * (r >> 3) + (r & 7); if (key > qidx) s[sb][r] = NEG_BIG; }
                }
            }
            if (MODE == 2) {
                const LAS float* tab = (const LAS float*)(lds + C::XOFF);
                if (kt + 2 >= diag) {
                    const int rel0 = qidx - (kt * TK + 8 * hi);
#pragma unroll
                    for (int sb = 0; sb < C::NSB; ++sb)
#pragma unroll
                        for (int r = 0; r < 16; ++r) { const int rel = rel0 - (32 * sb + 16 * (r >> 3) + (r & 7));
                            const int i0 = min(max(rel, -128), 128) + 128; s[sb][r] += tab[i0]; }
                } else {
                    const float c = tab[256];
#pragma unroll
                    for (int sb = 0; sb < C::NSB; ++sb)
#pragma unroll
                        for (int r = 0; r < 16; ++r) s[sb][r] += c;
                }
            }
            if (!bounded) {
                if (MODE != 0 && __any(moff != 0.f)) {
#pragma unroll
                    for (int sb = 0; sb < C::NSB; ++sb)
#pragma unroll
                        for (int r = 0; r < 16; ++r) s[sb][r] -= moff;
                }
                float mx = fmaxf(fmaxf(s[0][0], s[0][1]), s[0][2]);
#pragma unroll
                for (int sb = 0; sb < C::NSB; ++sb)
#pragma unroll
                    for (int r = (sb == 0 ? 3 : 0); r + 1 < 16; r += 2) mx = fmaxf(fmaxf(mx, s[sb][r]), s[sb][r + 1]);
                mx = fmaxf(mx, s[0][15]);
                mx = fmaxf(mx, __shfl_xor(mx, 32));
                if (__any(mx > THR)) {
                    const float dl = fmaxf(mx, 0.f), f = __builtin_amdgcn_exp2f(-dl);
#pragma unroll
                    for (int sb = 0; sb < C::NSB; ++sb)
#pragma unroll
                        for (int r = 0; r < 16; ++r) s[sb][r] -= dl;
                    if (MODE == 0) {
#pragma unroll
                        for (int r = 0; r < 16; ++r) cinit[r] -= dl;
                    } else moff += dl;
                    lsum *= f;
                    if (LMFMA) {
#pragma unroll
                        for (int r = 0; r < 16; ++r) lacc[r] *= f;
                    }
#pragma unroll
                    for (int db = 0; db < NDB; ++db)
#pragma unroll
                        for (int r = 0; r < 16; ++r) O[db][r] *= f;
                }
            }
            if (LMFMA) {
#pragma unroll
                for (int sb = 0; sb < C::NSB; ++sb)
#pragma unroll
                    for (int r = 0; r < 16; ++r) s[sb][r] = __builtin_amdgcn_exp2f(s[sb][r]);
            } else {
                float ps = 0.f;
#pragma unroll
                for (int sb = 0; sb < C::NSB; ++sb)
#pragma unroll
                    for (int r = 0; r < 16; ++r) { s[sb][r] = __builtin_amdgcn_exp2f(s[sb][r]); ps += s[sb][r]; }
                lsum += ps;
            }
            const LAS unsigned char* vb = lds + 2 * NP * C::KBUF + (cur * NP + p) * C::VBUF + (dsplit * 32 * NDB + pim) * C::VSB + hi * 16;
#pragma unroll
            for (int kg = 0; kg < C::NKS / PVB; ++kg) {
                bf16x8 vf[PVB][NDB];
#pragma unroll
                for (int k2 = 0; k2 < PVB; ++k2)
#pragma unroll
                    for (int db = 0; db < NDB; ++db) vf[k2][db] = *(const LAS bf16x8*)(vb + db * 32 * C::VSB + (PVB * kg + k2) * 32);
                u32x4 pw[PVB];
#pragma unroll
                for (int k2 = 0; k2 < PVB; ++k2) { const int ks = PVB * kg + k2, sb = ks >> 1, r0 = 8 * (ks & 1);
                    pw[k2].x = cvtpk(s[sb][r0 + 0], s[sb][r0 + 1]); pw[k2].y = cvtpk(s[sb][r0 + 2], s[sb][r0 + 3]); pw[k2].z = cvtpk(s[sb][r0 + 4], s[sb][r0 + 5]); pw[k2].w = cvtpk(s[sb][r0 + 6], s[sb][r0 + 7]); }
                __builtin_amdgcn_sched_barrier(0);
#pragma unroll
                for (int k2 = 0; k2 < PVB; ++k2)
#pragma unroll
                    for (int db = 0; db < NDB; ++db)
                        O[db] = __builtin_amdgcn_mfma_f32_32x32x16_bf16(vf[k2][db], __builtin_bit_cast(bf16x8, pw[k2]), O[db], 0, 0, 0);
                if (LMFMA) {
#pragma unroll
                    for (int k2 = 0; k2 < PVB; ++k2) lacc = __builtin_amdgcn_mfma_f32_32x32x16_bf16(onesf, __builtin_bit_cast(bf16x8, pw[k2]), lacc, 0, 0, 0);
                }
                __builtin_amdgcn_sched_barrier(0);
            }
        }
        if (DEEP) { if (p == 1) { if (more) { ATT_STORE(0, kt2 + 2, (cur ^ 1) * 2); ATT_STORE(1, kt2 + 3, (cur ^ 1) * 2 + 1); } __syncthreads(); cur ^= 1; } }
        else { if (more) ATT_STORE(0, kt + 1, cur ^ 1); __syncthreads(); cur ^= 1; }
        }
      }
    }
    if (LMFMA) lsum = lacc[0];
    else lsum += __shfl_xor(lsum, 32);
    lsum_out = lsum;
#undef ATT_LOAD
#undef ATT_GLD
#undef ATT_WAIT
#undef ATT_STORE
#undef ATT_QPROLOGUE
}

template <int NDB>
__device__ __forceinline__ void store_o(bf16_t* orow, const f32x16 (&O)[NDB], const float inv, const int hi) {
#pragma unroll
    for (int db = 0; db < NDB; ++db)
#pragma unroll
        for (int a = 0; a < 2; ++a) {
            u32x4 w; w.x = cvtpk(O[db][8 * a + 0] * inv, O[db][8 * a + 1] * inv); w.y = cvtpk(O[db][8 * a + 2] * inv, O[db][8 * a + 3] * inv);
            w.z = cvtpk(O[db][8 * a + 4] * inv, O[db][8 * a + 5] * inv); w.w = cvtpk(O[db][8 * a + 6] * inv, O[db][8 * a + 7] * inv);
            *(u32x4*)(orow + 32 * db + 16 * a + 8 * hi) = w;
        }
}
}
__device__ __forceinline__ float bf2f_u(unsigned short v) { return __uint_as_float((unsigned)v << 16); }

namespace cg = cooperative_groups;
#ifndef MK_SINGLE
#define MK_SINGLE 1
#endif
typedef unsigned short bf16;
typedef unsigned v4u __attribute__((ext_vector_type(4)));
typedef float f32x4 __attribute__((ext_vector_type(4)));
constexpr int NWAVES = 8, NTHREADS = 512;
constexpr int DM = 1024, NB = 32, SEQ = 2048, M = NB * SEQ, DEPTH = 4, DFF = 2816, NMEM = 256, MMEM = NB * NMEM;
constexpr int PP = 2560;
constexpr size_t MiB = 1u << 20;
constexpr size_t WS_SS = 1 * MiB, WS_SSMEM = 6 * MiB, WS_CS = 7 * MiB, WS_CSH = 11 * MiB, WS_W = 16 * MiB;
constexpr int GOFF = 143360;
constexpr size_t W_LAYER = 45 * MiB + MiB / 2;
constexpr size_t WO_1IN = 0, WO_1OUT = 11 * MiB, WO_2IN = 16 * MiB + MiB / 2, WO_2OUT = 27 * MiB + MiB / 2, WO_MIXIN = 33 * MiB, WO_MIXOUT = 39 * MiB + MiB / 2, WO_XQ = 41 * MiB + MiB / 2, WO_XO = 43 * MiB + MiB / 2;
constexpr size_t WS_WKV = WS_W + 4 * W_LAYER;
constexpr size_t WS_XB = 216 * MiB, WS_MEMB = 344 * MiB, WS_KX = 360 * MiB, WS_VXT = 376 * MiB, WS_R1 = 392 * MiB;
constexpr size_t WS_H = WS_R1, WS_P = WS_R1, WS_VT = WS_R1 + 320 * MiB, WS_OMIX = WS_VT + 128 * MiB, WS_QX = WS_R1, WS_OX = WS_R1 + 128 * MiB;
constexpr size_t WS_STASH = WS_OMIX + 128 * MiB;
constexpr size_t WS_END = WS_STASH + 32 * MiB;
static_assert(WS_WKV + 16 * MiB <= WS_XB && WS_H + (size_t)M * DFF * 2 <= WS_STASH && WS_P + (size_t)M * PP * 2 <= WS_VT, "ws map");
constexpr int LDS_BYTES = 147456;

struct Args {
    const float* in[23]; float* out; unsigned char* ws; double inv[8]; int ph_lo, ph_hi, zero_alpha, pad;
};

#define LDS_WAIT() asm volatile("s_waitcnt lgkmcnt(0)" ::: "memory")
__device__ __forceinline__ unsigned f2bf(float f) { unsigned u = __builtin_bit_cast(unsigned, f); return (u + 0x7fffu + ((u >> 16) & 1u)) >> 16; }
__device__ __forceinline__ unsigned pk2(float lo, float hi) { return f2bf(lo) | (f2bf(hi) << 16); }
__device__ __forceinline__ float wave_sum(float v) {
#pragma unroll
    for (int o = 1; o < 64; o <<= 1) v += __shfl_xor(v, o);
    return v;
}

__device__ __forceinline__ unsigned pkh2(float lo, float hi) { typedef _Float16 h2 __attribute__((ext_vector_type(2))); const h2 v = {(_Float16)lo, (_Float16)hi}; return __builtin_bit_cast(unsigned, v); }
__device__ __forceinline__ void p0_item_map(int it, int nnb, int Nsrc, int maptype, int& k0, int& n0, int& srcc0, int& nvalid) {
    const int kb = it / nnb, nb = it % nnb; k0 = kb * 64; n0 = nb * 32; srcc0 = n0; nvalid = 32;
    if (maptype == 0) { nvalid = Nsrc - n0; nvalid = nvalid < 0 ? 0 : (nvalid > 32 ? 32 : nvalid); }
    else if (maptype == 1) { const int tile = n0 >> 8, r = n0 & 255; srcc0 = (r < 128) ? tile * 128 + r : DFF + tile * 128 + (r - 128); }
    else {
        if (n0 < 1024) srcc0 = n0;
        else if (n0 < 2048) srcc0 = 1544 + (n0 - 1024);
        else if (n0 < 2304) { srcc0 = 1536 + (n0 - 2048); nvalid = (n0 == 2048) ? 8 : 0; if (nvalid == 0) srcc0 = 0; }
        else if (n0 < 2816) srcc0 = 1024 + (n0 - 2304);
        else srcc0 = 2568 + (n0 - 2816);
    }
}
__device__ __forceinline__ void p0_item_load(const float* W, int Nsrc, int k0, int srcc0, int nvalid, int lane, f32x4 (&wv)[8]) {
    const int c4 = lane & 7, r8 = lane >> 3;
#pragma unroll
    for (int i = 0; i < 8; ++i) { const int kk = 8 * i + r8;
        wv[i] = (4 * c4 < nvalid) ? *(const f32x4*)(W + (size_t)(k0 + kk) * Nsrc + srcc0 + 4 * c4) : (f32x4){0.f, 0.f, 0.f, 0.f}; }
}
__device__ __forceinline__ void p0_item_finish(const f32x4 (&wv)[8], int K, bf16* WT, int n0, const float* gain, LAS float* scr, int k0, int lane, bool f16) {
    const float gl = gain ? gain[k0 + lane] : 1.0f;
    const int c4 = lane & 7, r8 = lane >> 3;
#pragma unroll
    for (int i = 0; i < 8; ++i) { const int kk = 8 * i + r8; const float gk_ = __shfl(gl, kk); LAS float* d = scr + kk * 33 + 4 * c4;
        d[0] = wv[i][0] * gk_; d[1] = wv[i][1] * gk_; d[2] = wv[i][2] * gk_; d[3] = wv[i][3] * gk_; }
    LDS_WAIT();
    const int c8 = lane & 7;
#pragma unroll
    for (int j = 0; j < 4; ++j) { const int n = (lane >> 3) + 8 * j; const LAS float* s = scr + (8 * c8) * 33 + n;
        v4u o;
        if (f16) { o.x = pkh2(s[0 * 33], s[1 * 33]); o.y = pkh2(s[2 * 33], s[3 * 33]); o.z = pkh2(s[4 * 33], s[5 * 33]); o.w = pkh2(s[6 * 33], s[7 * 33]); }
        else { o.x = pk2(s[0 * 33], s[1 * 33]); o.y = pk2(s[2 * 33], s[3 * 33]); o.z = pk2(s[4 * 33], s[5 * 33]); o.w = pk2(s[6 * 33], s[7 * 33]); }
        *(v4u*)(WT + (size_t)(n0 + n) * K + k0 + 8 * c8) = o; }
    LDS_WAIT();
}

__device__ __forceinline__ void p0_matrix(const float* W, int K, int Nsrc, bf16* WT, int Ndst, int maptype, const float* gain, LAS float* scr, int gw, int NGW, int lane, bool f16) {
    const int nkb = K / 64, nnb = Ndst / 32, items = nkb * nnb;
    int it = gw; if (it >= items) return;
    int k0, n0, srcc0, nvalid; f32x4 cur[8], nxt[8];
    p0_item_map(it, nnb, Nsrc, maptype, k0, n0, srcc0, nvalid);
    p0_item_load(W, Nsrc, k0, srcc0, nvalid, lane, cur);
    for (;;) {
        const int itn = it + NGW; const bool more = itn < items; int k0n = 0, n0n = 0, srcn = 0, nvn = 0;
        if (more) { p0_item_map(itn, nnb, Nsrc, maptype, k0n, n0n, srcn, nvn); p0_item_load(W, Nsrc, k0n, srcn, nvn, lane, nxt); }
        p0_item_finish(cur, K, WT, n0, gain, scr, k0, lane, f16);
        if (!more) break;
#pragma unroll
        for (int i = 0; i < 8; ++i) cur[i] = nxt[i];
        it = itn; k0 = k0n; n0 = n0n;
    }
}

__device__ __forceinline__ void rows4_to_bf16_ss(const float* x, bf16* xb, float* ssp, _Float16* xh, int m0, int stride, int lane, int nrows) {
    f32x4 v[4][4];
#pragma unroll
    for (int r = 0; r < 4; ++r)
#pragma unroll
        for (int j = 0; j < 4; ++j) v[r][j] = (m0 + r * stride < nrows) ? ((const f32x4*)(x + (size_t)(m0 + r * stride) * DM))[64 * j + lane] : (f32x4){0.f, 0.f, 0.f, 0.f};
#pragma unroll
    for (int r = 0; r < 4; ++r) { if (m0 + r * stride >= nrows) continue; const size_t row = (size_t)(m0 + r * stride); float s = 0.f;
        unsigned long long* o8 = (unsigned long long*)(xb + row * DM) + lane;
#pragma unroll
        for (int j = 0; j < 4; ++j) { const f32x4 t = v[r][j]; s += (t.x * t.x + t.y * t.y) + (t.z * t.z + t.w * t.w);
            if (xb) o8[64 * j] = (unsigned long long)pk2(t.x, t.y) | ((unsigned long long)pk2(t.z, t.w) << 32);
            if (xh) ((pg8::f16x4*)(xh + row * DM))[64 * j + lane] = (pg8::f16x4){(_Float16)t.x, (_Float16)t.y, (_Float16)t.z, (_Float16)t.w}; }
        s = wave_sum(s);
        if (lane < 16) ssp[row * 16 + lane] = (lane == 0) ? s : 0.f; }
}

__device__ __forceinline__ void sincos_d(double a, float& c, float& s) {
    const double k = rint(a * 0.15915494309189535);
    const float r = (float)fma(-k, 6.283185307179586, a);
    const float r2 = r * r;
    float ps = 1.9572941e-20f;
    ps = fmaf(ps, r2, -8.2206352e-18f);
    ps = fmaf(ps, r2, 2.8114573e-15f);
    ps = fmaf(ps, r2, -7.6471637e-13f);
    ps = fmaf(ps, r2, 1.6059044e-10f);
    ps = fmaf(ps, r2, -2.5052108e-8f);
    ps = fmaf(ps, r2, 2.7557319e-6f);
    ps = fmaf(ps, r2, -1.9841270e-4f);
    ps = fmaf(ps, r2, 8.3333333e-3f);
    ps = fmaf(ps, r2, -1.6666667e-1f);
    ps = fmaf(ps, r2, 1.0f);
    float pc = -8.8967791e-22f;
    pc = fmaf(pc, r2, 4.1103176e-19f);
    pc = fmaf(pc, r2, -1.5619207e-16f);
    pc = fmaf(pc, r2, 4.7794773e-14f);
    pc = fmaf(pc, r2, -1.1470746e-11f);
    pc = fmaf(pc, r2, 2.0876757e-9f);
    pc = fmaf(pc, r2, -2.7557319e-7f);
    pc = fmaf(pc, r2, 2.4801587e-5f);
    pc = fmaf(pc, r2, -1.3888889e-3f);
    pc = fmaf(pc, r2, 4.1666667e-2f);
    pc = fmaf(pc, r2, -0.5f);
    pc = fmaf(pc, r2, 1.0f);
    s = ps * r; c = pc;
}

struct Ptrs {
    const float *x, *mem; const int* pos; const float *ln_g, *f1in, *f1out, *f2in, *f2out, *e_win, *e_fb, *e_qkg, *e_lam, *e_sub, *e_wout, *o_win, *o_conv, *o_qkg, *o_rel, *o_wout, *xwq, *xwkv, *xqkg, *xwo;
};

__device__ __forceinline__ void p0_prologue(const Ptrs& I, const Args& A, unsigned char* ws, LAS unsigned char* lds, int tid_in, float* xh_out) {
    int tid = tid_in; asm volatile("" : "+v"(tid));
    const int lane = tid & 63, wave = tid >> 6;
    LAS float* scr = (LAS float*)(lds + wave * 16384);
    const int gw = blockIdx.x * NWAVES + wave, NGW = gridDim.x * NWAVES;
#pragma unroll 1
    for (int id = 0; id < 9 * DEPTH; ++id) {
        const int l = id / 9, kind = id % 9, e = l >> 1; const bool ev = (l & 1) == 0;
        unsigned char* wl = ws + WS_W + (size_t)l * W_LAYER; const float* g = I.ln_g + (size_t)l * 5 * DM;
        const float* W; int K, Nsrc, Ndst, maptype; bf16* WT; const float* gain; bool f16;
        if (kind == 0)      { W = I.f1in + (size_t)l * DM * 2 * DFF; K = DM; Nsrc = 2 * DFF; WT = (bf16*)(wl + WO_1IN); Ndst = 2 * DFF; maptype = 1; gain = g + 0 * DM; f16 = true; }
        else if (kind == 1) { W = I.f1out + (size_t)l * DFF * DM; K = DFF; Nsrc = DM; WT = (bf16*)(wl + WO_1OUT); Ndst = DM; maptype = 0; gain = nullptr; f16 = false; }
        else if (kind == 2) { W = I.f2in + (size_t)l * DM * 2 * DFF; K = DM; Nsrc = 2 * DFF; WT = (bf16*)(wl + WO_2IN); Ndst = 2 * DFF; maptype = 1; gain = g + 4 * DM; f16 = true; }
        else if (kind == 3) { W = I.f2out + (size_t)l * DFF * DM; K = DFF; Nsrc = DM; WT = (bf16*)(wl + WO_2OUT); Ndst = DM; maptype = 0; gain = nullptr; f16 = false; }
        else if (kind == 4) { if (ev) { W = I.e_win + (size_t)e * DM * 3080; Nsrc = 3080; Ndst = 3328; maptype = 2; } else { W = I.o_win + (size_t)e * DM * 3072; Nsrc = 3072; Ndst = 3072; maptype = 0; }
                              K = DM; WT = (bf16*)(wl + WO_MIXIN); gain = g + 1 * DM; f16 = true; }
        else if (kind == 5) { W = (ev ? I.e_wout : I.o_wout) + (size_t)e * DM * DM; K = DM; Nsrc = DM; WT = (bf16*)(wl + WO_MIXOUT); Ndst = DM; maptype = 0; gain = nullptr; f16 = false; }
        else if (kind == 6) { W = I.xwq + (size_t)l * DM * DM; K = DM; Nsrc = DM; WT = (bf16*)(wl + WO_XQ); Ndst = DM; maptype = 0; gain = g + 2 * DM; f16 = true; }
        else if (kind == 7) { W = I.xwo + (size_t)l * DM * DM; K = DM; Nsrc = DM; WT = (bf16*)(wl + WO_XO); Ndst = DM; maptype = 0; gain = nullptr; f16 = false; }
        else                { W = I.xwkv + (size_t)l * DM * 2 * DM; K = DM; Nsrc = 2 * DM; WT = (bf16*)(ws + WS_WKV) + (size_t)l * 2048 * DM; Ndst = 2 * DM; maptype = 0; gain = g + 3 * DM; f16 = true; }
        p0_matrix(W, K, Nsrc, WT, Ndst, maptype, gain, scr, gw, NGW, lane, f16);
    }
    for (int m = gw; m < M; m += 4 * NGW) rows4_to_bf16_ss(I.x, nullptr, (float*)(ws + WS_SS), (_Float16*)xh_out, m, NGW, lane, M);
    for (int m = gw; m < MMEM; m += 4 * NGW) rows4_to_bf16_ss(I.mem, nullptr, (float*)(ws + WS_SSMEM), (_Float16*)(ws + WS_MEMB), m, NGW, lane, MMEM);
    float* cs = (float*)(ws + WS_CS);
    for (int it = blockIdx.x * NTHREADS + tid; it < M * 8; it += gridDim.x * NTHREADS) {
        const int m = it >> 3, i = it & 7; float c, s; sincos_d((double)I.pos[m] * A.inv[i], c, s);
        cs[(size_t)m * 16 + i] = c; cs[(size_t)m * 16 + 8 + i] = s;
        _Float16* csh = (_Float16*)(ws + WS_CSH); csh[(size_t)m * 16 + i] = (_Float16)c; csh[(size_t)m * 16 + 8 + i] = (_Float16)s;
    }
}

__device__ __forceinline__ float grp_sum(float v, int n) { for (int o = 1; o < n; o <<= 1) v += __shfl_xor(v, o); return v; }
__device__ __forceinline__ void kprep_phase(unsigned char* ws, int tid_in, int kind, const float* gains, const int*  ) {
    using namespace att;
    int tid = tid_in; asm volatile("" : "+v"(tid));
    const int lane = tid & 63, wave = tid >> 6;
    const int gw = blockIdx.x * NWAVES + wave, NGW = gridDim.x * NWAVES;
    if (kind == 2) {
        bf16* KX = (bf16*)(ws + WS_KX);
        float g0[8];
#pragma unroll
        for (int e = 0; e < 8; ++e) g0[e] = gains[256 + (lane & 31) * 8 + e];
        for (int m = gw; m < MMEM; m += 4 * NGW) {
            u32x4 ra[4], rb[4];
#pragma unroll
            for (int r = 0; r < 4; ++r) { const int row = m + r * NGW; const bool ok = row < MMEM; const bf16* rp = KX + (size_t)(ok ? row : 0) * DM + lane * 8;
                ra[r] = *(const u32x4*)rp; rb[r] = *(const u32x4*)(rp + 512); }
#pragma unroll
            for (int r = 0; r < 4; ++r) { const int row = m + r * NGW; if (row >= MMEM) continue; bf16* rp = KX + (size_t)row * DM + lane * 8;
                float x0[8], x1[8]; unpack8(ra[r], x0); unpack8(rb[r], x1); float s0 = 0.f, s1 = 0.f;
#pragma unroll
                for (int e = 0; e < 8; ++e) { s0 += x0[e] * x0[e]; s1 += x1[e] * x1[e]; }
                s0 = grp_sum(s0, 32); s1 = grp_sum(s1, 32);
                const float q0 = rsqrtf(s0 * (1.0f / 256.0f) + 1e-6f), q1 = rsqrtf(s1 * (1.0f / 256.0f) + 1e-6f);
#pragma unroll
                for (int e = 0; e < 8; ++e) { x0[e] *= q0 * g0[e]; x1[e] *= q1 * g0[e]; }
                *(u32x4*)rp = pack8(x0); *(u32x4*)(rp + 512) = pack8(x1); }
        }
    } else {
        bf16* P = (bf16*)(ws + WS_P);
        const _Float16* CSH = (const _Float16*)(ws + WS_CSH);
        const int pc = lane & 7, c0 = (kind == 0 ? 512 : 2048) + lane * 8;
        float ga[8], gb[8];
#pragma unroll
        for (int e = 0; e < 8; ++e) { ga[e] = gains[64 + pc * 8 + e]; gb[e] = (kind == 0) ? gains[192 + pc * 8 + e] : 0.f; }
        for (int m = gw; m < M; m += 4 * NGW) {
            u32x4 ra[4], rb[4], ca[4], cb[4];
#pragma unroll
            for (int r = 0; r < 4; ++r) { const int row = m + r * NGW; const bool ok = row < M; const bf16* rp = P + (size_t)(ok ? row : 0) * PP + c0;
                ra[r] = *(const u32x4*)rp;
                if (kind == 0) { rb[r] = *(const u32x4*)(rp + 1024); const u32x4* cp = (const u32x4*)(CSH + (size_t)(ok ? row : 0) * 16); ca[r] = cp[0]; cb[r] = cp[1]; } }
#pragma unroll
            for (int r = 0; r < 4; ++r) { const int row = m + r * NGW; if (row >= M) continue; bf16* rp = P + (size_t)row * PP + c0;
                float x0[8]; unpack8(ra[r], x0); float s0 = 0.f;
#pragma unroll
                for (int e = 0; e < 8; ++e) s0 += x0[e] * x0[e];
                s0 = grp_sum(s0, 8);
                const float q0 = rsqrtf(s0 * (1.0f / 64.0f) + 1e-6f);
#pragma unroll
                for (int e = 0; e < 8; ++e) x0[e] *= q0 * ga[e];
                if (kind == 0) {
                    const f16x8 ch = __builtin_bit_cast(f16x8, ca[r]), sh = __builtin_bit_cast(f16x8, cb[r]);
                    float x1[8]; unpack8(rb[r], x1); float s1 = 0.f;
#pragma unroll
                    for (int e = 0; e < 8; ++e) s1 += x1[e] * x1[e];
                    s1 = grp_sum(s1, 8);
                    const float q1 = rsqrtf(s1 * (1.0f / 64.0f) + 1e-6f);
#pragma unroll
                    for (int e = 0; e < 8; ++e) { x1[e] *= q1 * gb[e]; const float xp = __shfl_xor(x1[e], 1); const float c = (float)ch[e], sn = (float)sh[e];
                        const float rA = x1[e] * c - xp * sn, rB = x1[e] * c + xp * sn; x1[e] = (pc == 0) ? rA : ((pc == 1) ? rB : x1[e]); }
                    *(u32x4*)(rp + 1024) = pack8(x1);
                }
                *(u32x4*)rp = pack8(x0); }
        }
    }
}

__device__ __forceinline__ int vcu_index() { const int G = gridDim.x, bx = blockIdx.x; return (G % 8 == 0) ? (bx % 8) * (G / 8) + bx / 8 : bx; }
__device__ __forceinline__ float lds_absmax(const LAS float* p, int n, int lane) {
    float v = 0.f; for (int i = lane; i < n; i += 64) v = fmaxf(v, fabsf(p[i]));
#pragma unroll
    for (int o = 1; o < 64; o <<= 1) v = fmaxf(v, __shfl_xor(v, o));
    return v;
}

__device__ __forceinline__ float log_sigmoid(float z) { return (z >= 0.f) ? -log1pf(__expf(-z)) : (z - log1pf(__expf(z))); }

__device__ __forceinline__ void attn_even_phase(const Ptrs& I, unsigned char* ws, LAS unsigned char* lds, int tid_in, int layer, float* stash_base) {
    int tid = tid_in; asm volatile("" : "+v"(tid));
    using namespace att;
    const int lane = tid & 63, wave = __builtin_amdgcn_readfirstlane(tid >> 6), hi = lane >> 5, q31 = lane & 31, e = layer >> 1;
    const bf16* P = (const bf16*)(ws + WS_P); const bf16* VT = (const bf16*)(ws + WS_VT); bf16* OM = (bf16*)(ws + WS_OMIX);
    const float* CS = (const float*)(ws + WS_CS);
    const float* qkg_g = I.e_qkg + (size_t)e * 4 * 64;
    LAS float* qkg = (LAS float*)(lds + GOFF);
    const _Float16* CSH = (const _Float16*)(ws + WS_CSH);
    if (tid < 256) qkg[tid] = qkg_g[tid];
    __syncthreads();
    const bool bndA = 8.0f * att::LOG2E * lds_absmax(qkg, 64, lane) * lds_absmax(qkg + 64, 64, lane) < 60.0f;
    const bool bndB = 8.0f * att::LOG2E * lds_absmax(qkg + 128, 64, lane) * lds_absmax(qkg + 192, 64, lane) < 60.0f;
    for (int v = vcu_index(); v < 256; v += gridDim.x) {
        {
            const int b = v >> 3, h = v & 7;
            typedef Cfg<64, 2, 1> C0;
            LAS float* Fl = (LAS float*)(lds + C0::XOFF); LAS float* wsum = (LAS float*)(lds + C0::XOFF + 8192);
            {
                const float fb = I.e_fb[e * 8 + h]; float vv[4]; float run = 0.f;
#pragma unroll
                for (int j = 0; j < 4; ++j) { const int t = 4 * tid + j; const float af = bf2f_u(P[(size_t)(b * SEQ + t) * PP + 2048 + h]); run += log_sigmoid(af + fb); vv[j] = run; }
                float inc = run;
#pragma unroll
                for (int o = 1; o < 64; o <<= 1) { const float n = __shfl_up(inc, o); if (lane >= o) inc += n; }
                if (lane == 63) wsum[wave] = inc;
                __syncthreads();
                float base = inc - run;
                for (int w = 0; w < wave; ++w) base += wsum[w];
#pragma unroll
                for (int j = 0; j < 4; ++j) Fl[4 * tid + j] = (base + vv[j]) * LOG2E;
                __syncthreads();
            }
#pragma unroll 1
            for (int qb = 0; qb < 8; ++qb) {
                const int c = 4 * qb + (wave >> 1), qidx = 256 * qb + 32 * wave + q31; const size_t row = (size_t)b * SEQ + qidx;
                f32x16 O[2]; float l;
                attn_core<64, 2, 1, 0, 64>(lds, tid, P + row * PP + h * 64, qkg, qkg + 64, P + (size_t)b * SEQ * PP + 512 + h * 64, PP,
                                       VT + (size_t)(b * 512 + h * 64) * SEQ, SEQ, 0, 4 * qb + 4, 0, c, c, qidx, nullptr, nullptr, 0, bndA, O, l);
                store_o<2>(OM + row * DM + h * 64, O, 1.0f / l, hi);
            }
        }
        {
            asm volatile("" : "+v"(tid));
            const int pr = v >> 1, b = pr >> 2, h = pr & 3, odd = v & 1;
            const float lam_init = 0.8f - 0.6f * __expf(-0.3f * (float)layer);
            float lam;
            { const float* lp = I.e_lam + (size_t)e * 4 * 64; const float sa = wave_sum(lp[lane] * lp[64 + lane]), sb = wave_sum(lp[128 + lane] * lp[192 + lane]); lam = __expf(sa) - __expf(sb) + lam_init; }
            const float* sub = I.e_sub + (size_t)e * 128;
#pragma unroll 1
            for (int qi = 0; qi < 4; ++qi) {
                const int qb = odd ? ((qi == 0) ? 1 : (qi == 1) ? 2 : (qi == 2) ? 5 : 6) : ((qi == 0) ? 0 : (qi == 1) ? 3 : (qi == 2) ? 4 : 7);
                const int c = 4 * qb + (wave >> 1), qidx = 256 * qb + 32 * wave + q31; const size_t row = (size_t)b * SEQ + qidx;
                f32x16 O1[4]; float l1;
                float* stash = stash_base + (size_t)blockIdx.x * 32768 + tid * 64;
                {
                    attn_core<64, 4, 1, 1, 64>(lds, tid, P + row * PP + 1024 + h * 128, qkg + 128, qkg + 192, P + (size_t)b * SEQ * PP + 1536 + h * 128, PP,
                                           VT + (size_t)32 * 512 * SEQ + (size_t)(b * 512 + h * 128) * SEQ, SEQ, 0, 4 * qb + 4, 0, c, c, qidx, CS + row * 16, CSH + (size_t)b * SEQ * 16, 0, bndB, O1, l1);
                    const float i1 = 1.0f / l1;
#pragma unroll
                    for (int db = 0; db < 4; ++db)
#pragma unroll
                        for (int r4 = 0; r4 < 4; ++r4) *(f32x4*)(stash + db * 16 + 4 * r4) = (f32x4){O1[db][4 * r4] * i1, O1[db][4 * r4 + 1] * i1, O1[db][4 * r4 + 2] * i1, O1[db][4 * r4 + 3] * i1};
                }
                f32x16 O2[4]; float l2;
                attn_core<64, 4, 1, 1, 64>(lds, tid, P + row * PP + 1024 + h * 128 + 64, qkg + 128, qkg + 192, P + (size_t)b * SEQ * PP + 1536 + h * 128 + 64, PP,
                                       VT + (size_t)32 * 512 * SEQ + (size_t)(b * 512 + h * 128) * SEQ, SEQ, 0, 4 * qb + 4, 0, c, c, qidx, CS + row * 16, CSH + (size_t)b * SEQ * 16, 0, bndB, O2, l2);
                const float i2 = lam / l2; float ss = 0.f;
#pragma unroll
                for (int db = 0; db < 4; ++db)
#pragma unroll
                    for (int r4 = 0; r4 < 4; ++r4) { const f32x4 o1 = *(const f32x4*)(stash + db * 16 + 4 * r4);
#pragma unroll
                        for (int j = 0; j < 4; ++j) { const float d = o1[j] - i2 * O2[db][4 * r4 + j]; O2[db][4 * r4 + j] = d; ss += d * d; } }
                ss += __shfl_xor(ss, 32);
                const float rs = rsqrtf(ss * (1.0f / 128.0f) + 1e-6f) * (1.0f - lam_init);
#pragma unroll
                for (int db = 0; db < 4; ++db)
#pragma unroll
                    for (int a = 0; a < 2; ++a) { const float* gp = sub + 32 * db + 16 * a + 8 * hi;
#pragma unroll
                        for (int ee = 0; ee < 8; ++ee) O2[db][8 * a + ee] *= gp[ee]; }
                store_o<4>(OM + row * DM + 512 + h * 128, O2, rs, hi);
            }
        }
    }
}

__device__ __forceinline__ void attn_odd_phase(const Ptrs& I, unsigned char* ws, LAS unsigned char* lds, int tid_in, int layer) {
    int tid = tid_in; asm volatile("" : "+v"(tid));
    using namespace att;
    const int lane = tid & 63, wave = __builtin_amdgcn_readfirstlane(tid >> 6), hi = lane >> 5, q31 = lane & 31, o = layer >> 1;
    const bf16* P = (const bf16*)(ws + WS_P); const bf16* VT = (const bf16*)(ws + WS_VT); bf16* OM = (bf16*)(ws + WS_OMIX);
    const float* qkg_g = I.o_qkg + (size_t)o * 2 * 64;
    LAS float* qkg = (LAS float*)(lds + GOFF);
    if (tid < 128) qkg[tid] = qkg_g[tid];
    __syncthreads();
    for (int v = vcu_index(); v < 256; v += gridDim.x) {
        {
            const float* cw = I.o_conv + (size_t)o * 3 * 512 + lane * 8; float w0[8], w1[8], w2[8];
#pragma unroll
            for (int ee = 0; ee < 8; ++ee) { w0[ee] = cw[ee]; w1[ee] = cw[512 + ee]; w2[ee] = cw[1024 + ee]; }
            for (int rr = wave; rr < 256; rr += NWAVES) {
                const int row = 256 * v + rr, t = row & (SEQ - 1); const bf16* pr = P + (size_t)row * PP + lane * 8;
                float cb[8], u0[8], u1[8], u2[8], a[8], bb[8];
                unpack8(*(const u32x4*)(pr), cb);
                unpack8(*(const u32x4*)(pr + 512), a); unpack8(*(const u32x4*)(pr + 1024), bb);
#pragma unroll
                for (int ee = 0; ee < 8; ++ee) u2[ee] = a[ee] * bb[ee];
                if (t >= 1) { unpack8(*(const u32x4*)(pr - PP + 512), a); unpack8(*(const u32x4*)(pr - PP + 1024), bb);
#pragma unroll
                    for (int ee = 0; ee < 8; ++ee) u1[ee] = a[ee] * bb[ee]; }
                else {
#pragma unroll
                    for (int ee = 0; ee < 8; ++ee) u1[ee] = 0.f; }
                if (t >= 2) { unpack8(*(const u32x4*)(pr - 2 * PP + 512), a); unpack8(*(const u32x4*)(pr - 2 * PP + 1024), bb);
#pragma unroll
                    for (int ee = 0; ee < 8; ++ee) u0[ee] = a[ee] * bb[ee]; }
                else {
#pragma unroll
                    for (int ee = 0; ee < 8; ++ee) u0[ee] = 0.f; }
                float y[8];
#pragma unroll
                for (int ee = 0; ee < 8; ++ee) y[ee] = cb[ee] * (w0[ee] * u0[ee] + w1[ee] * u1[ee] + w2[ee] * u2[ee]);
                *(u32x4*)(OM + (size_t)row * DM + lane * 8) = pack8(y);
            }
        }
        {
            asm volatile("" : "+v"(tid));
            const int b = v >> 3, h = v & 7;
            typedef Cfg<64, 2, 1> C0;
            LAS float* tab = (LAS float*)(lds + C0::XOFF);
            __syncthreads();
            if (tid < 257) tab[tid] = I.o_rel[((size_t)o * 8 + h) * 257 + tid] * LOG2E;
            __syncthreads();
            const bool bnd = 8.0f * att::LOG2E * lds_absmax(qkg, 64, lane) * lds_absmax(qkg + 64, 64, lane) + lds_absmax(tab, 257, lane) < 60.0f;
#pragma unroll 1
            for (int qb = 0; qb < 8; ++qb) {
                const int c = 4 * qb + (wave >> 1), qidx = 256 * qb + 32 * wave + q31; const size_t row = (size_t)b * SEQ + qidx;
                const int kt0 = (4 * qb - 8) > 0 ? (4 * qb - 8) : 0, wlo = (c - 8) > 0 ? (c - 8) : 0;
                f32x16 O[2]; float l;
                attn_core<64, 2, 1, 2, 64>(lds, tid, P + row * PP + 1536 + h * 64, qkg, qkg + 64, P + (size_t)b * SEQ * PP + 2048 + h * 64, PP,
                                       VT + (size_t)(b * 512 + h * 64) * SEQ, SEQ, kt0, 4 * qb + 4, wlo, c, c, qidx, nullptr, nullptr, 0, bnd, O, l);
                store_o<2>(OM + row * DM + 512 + h * 64, O, 1.0f / l, hi);
            }
        }
    }
}

__device__ __forceinline__ void attn_cross_phase(const Ptrs& I, unsigned char* ws, LAS unsigned char* lds, int tid_in, int layer) {
    int tid = tid_in; asm volatile("" : "+v"(tid));
    using namespace att;
    const int lane = tid & 63, wave = __builtin_amdgcn_readfirstlane(tid >> 6), hi = lane >> 5, q31 = lane & 31;
    const bf16* QX = (const bf16*)(ws + WS_QX); const bf16* KX = (const bf16*)(ws + WS_KX); const bf16* VXT = (const bf16*)(ws + WS_VXT); bf16* OX = (bf16*)(ws + WS_OX);
    const float* qkg_g = I.xqkg + (size_t)layer * 2 * 256;
    LAS float* qkg = (LAS float*)(lds + GOFF);
    qkg[tid] = qkg_g[tid];
    __syncthreads();
    const bool bnd = 16.0f * att::LOG2E * lds_absmax(qkg, 256, lane) * lds_absmax(qkg + 256, 256, lane) < 60.0f;
    for (int v = vcu_index(); v < 256; v += gridDim.x) {
        const int pr = v >> 1, b = pr >> 2, h = pr & 3, ds = wave >> 2;
#pragma unroll 1
        for (int qi = 0; qi < 8; ++qi) {
            const int qblk = 8 * (v & 1) + qi, qidx = 128 * qblk + 32 * (wave & 3) + q31; const size_t row = (size_t)b * SEQ + qidx;
            f32x16 O[4]; float l;
            attn_core<256, 4, 2, 3, 32>(lds, tid, QX + row * DM + h * 256, qkg, qkg + 256, KX + (size_t)b * NMEM * DM + h * 256, DM,
                                    VXT + (size_t)(b * 1024 + h * 256) * NMEM, NMEM, 0, 8, 0, 7, 0, qidx, nullptr, nullptr, ds, bnd, O, l);
            store_o<4>(OX + row * DM + h * 256 + ds * 128, O, 1.0f / l, hi);
        }
    }
}

#define XB_TMO      128
#define XB_XCNT(j)  (256  + 64 * (j))
#define XB_XSUB(j)  (1280 + 64 * (j))
#define XB_XGEN(j)  (2304 + 64 * (j))
#define XB_TOP      3328
#define XB_TOPGEN   3392
#define XCD_BAR_WORDS 3456
#define XB_SPIN_CAP (1u << 18)

__device__ __forceinline__ unsigned xb_ld(unsigned* p)              { return __hip_atomic_load(p, __ATOMIC_RELAXED, __HIP_MEMORY_SCOPE_AGENT); }
__device__ __forceinline__ unsigned xb_add(unsigned* p, unsigned v) { return __hip_atomic_fetch_add(p, v, __ATOMIC_RELAXED, __HIP_MEMORY_SCOPE_AGENT); }
__device__ __forceinline__ unsigned xb_xcc_id() { return (unsigned)__builtin_amdgcn_s_getreg((3 << 11) | 20) & 0xFu; }
#define XB_SPIN(cond, bar) do { unsigned _sp = 0; while (cond) { __builtin_amdgcn_s_sleep(1); \
    if ((++_sp & 255u) == 0u) { if (xb_ld(&(bar)[XB_TMO])) break; if (_sp > XB_SPIN_CAP) { atomicAdd(&(bar)[XB_TMO], 1u); break; } } } } while (0)

struct XcdBarrier {
    unsigned* bar; unsigned x;
    volatile LAS unsigned* st;
};

__device__ __forceinline__ XcdBarrier xcd_barrier_post(unsigned* bar, volatile LAS unsigned* st) {
    XcdBarrier b; b.bar = bar; b.x = xb_xcc_id(); b.st = st;
    if (threadIdx.x == 0) (void)xb_add(&bar[XB_XCNT(b.x)], 1u);
    return b;
}
__device__ __forceinline__ void xcd_barrier_complete(unsigned* bar, unsigned x, unsigned& nloc, unsigned& nx) {
    const unsigned G = gridDim.x * gridDim.y * gridDim.z;
    unsigned sum, cnt, mine, sp = 0u;
    for (;;) {
        sum = 0u; cnt = 0u; mine = 0u;
#pragma unroll
        for (unsigned j = 0; j < 16; ++j) { const unsigned c = xb_ld(&bar[XB_XCNT(j)]); sum += c; cnt += (c > 0u) ? 1u : 0u; mine = (j == x) ? c : mine; }
        if (sum == G) break;
        __builtin_amdgcn_s_sleep(1);
        if ((++sp & 255u) == 0u) { if (xb_ld(&bar[XB_TMO])) break; if (sp > XB_SPIN_CAP) { atomicAdd(&bar[XB_TMO], 1u); break; } }
    }
    nloc = mine > 0u ? mine : 1u; nx = cnt > 0u ? cnt : 1u;
}

__device__ __forceinline__ void xcd_barrier(const XcdBarrier& b) {
    asm volatile("s_waitcnt vmcnt(0)" ::: "memory");
    __syncthreads();
    if (threadIdx.x == 0) {
        unsigned* bar = b.bar;
        __builtin_amdgcn_s_waitcnt(0);
        unsigned nloc = b.st[0], nx = b.st[1];
        if (nloc == 0u) { xcd_barrier_complete(bar, b.x, nloc, nx); b.st[0] = nloc; b.st[1] = nx; }
        const unsigned old = xb_add(&bar[XB_XSUB(b.x)], 1u);
        const unsigned gen = old / nloc;
        if (old + 1u == (gen + 1u) * nloc) {
            __builtin_amdgcn_fence(__ATOMIC_RELEASE, "agent");
            asm volatile("s_waitcnt vmcnt(0)" ::: "memory");
            const unsigned og = xb_add(&bar[XB_TOP], 1u);
            const unsigned tg = og / nx;
            if (og + 1u == (tg + 1u) * nx) xb_add(&bar[XB_TOPGEN], 1u);
            else XB_SPIN(xb_ld(&bar[XB_TOPGEN]) == tg, bar);
            __builtin_amdgcn_fence(__ATOMIC_ACQUIRE, "agent");
            xb_add(&bar[XB_XGEN(b.x)], 1u);
            asm volatile("s_waitcnt vmcnt(0)" ::: "memory");
        } else {
            XB_SPIN(xb_ld(&bar[XB_XGEN(b.x)]) == gen, bar);
            __builtin_amdgcn_fence(__ATOMIC_ACQUIRE, "agent");
            asm volatile("s_waitcnt vmcnt(0)" ::: "memory");
        }
    }
    __syncthreads();
}

#define GPTR0(T, v) ((T)(__attribute__((address_space(1))) unsigned char*)(v))
__global__ void __launch_bounds__(NTHREADS, 2) mega_fwd(Args A) {
    extern __shared__ __attribute__((aligned(16))) unsigned char smem[];
    LAS unsigned char* lds = (LAS unsigned char*)smem;
    volatile LAS unsigned* bar_st = (volatile LAS unsigned*)(lds + GOFF + 2048);
    if (threadIdx.x < 2) bar_st[threadIdx.x] = 0u;
    __syncthreads();
    XcdBarrier xbar = xcd_barrier_post((unsigned*)GPTR0(unsigned char*, (unsigned long long)A.ws), bar_st);
    for (int ph = A.ph_lo; ph < A.ph_hi; ++ph) {
        const int tid = threadIdx.x;
#define GPTR(T, v) ((T)(__attribute__((address_space(1))) unsigned char*)(v))
        unsigned long long wsi = (unsigned long long)A.ws; asm volatile("" : "+s"(wsi));
        unsigned char* ws = GPTR(unsigned char*, wsi);
        float* const outp = GPTR(float*, (unsigned long long)A.out);
        const __attribute__((address_space(4))) unsigned char* kp = (const __attribute__((address_space(4))) unsigned char*)__builtin_amdgcn_kernarg_segment_ptr();
        asm volatile("" : "+s"(kp));
#define INP(k) GPTR(const float*, ((const unsigned long long __attribute__((address_space(4)))*)kp)[k])
        Ptrs I;
        I.x = INP(0); I.mem = INP(1); I.pos = (const int*)INP(2); I.ln_g = INP(3); I.f1in = INP(4); I.f1out = INP(5); I.f2in = INP(6); I.f2out = INP(7);
        I.e_win = INP(8); I.e_fb = INP(9); I.e_qkg = INP(10); I.e_lam = INP(11); I.e_sub = INP(12); I.e_wout = INP(13);
        I.o_win = INP(14); I.o_conv = INP(15); I.o_qkg = INP(16); I.o_rel = INP(17); I.o_wout = INP(18);
        I.xwq = INP(19); I.xwkv = INP(20); I.xqkg = INP(21); I.xwo = INP(22);
#undef INP
        float* SSb = (float*)(ws + WS_SS);
        const bf16* XB = nullptr;
        if (ph == 0) {
#ifndef NO_P0
            p0_prologue(I, A, ws, lds, tid, outp);
#endif
        } else {
            const int l = (ph - 1) / 12, kq = (ph - 1) % 12; const bool even = (l & 1) == 0;
            const int k = (kq <= 2) ? kq : (kq == 3) ? 100 : (kq <= 6) ? kq - 1 : (kq == 7) ? 101 : kq - 2;
            unsigned char* wl = ws + WS_W + (size_t)l * W_LAYER;
            XB = (l == DEPTH - 1 && k == 8) ? (const bf16*)(ws + WS_OMIX) : (const bf16*)outp;
            if (k == 0 || k == 8) {
                pg8::Gemm g{XB, (const bf16*)(wl + (k == 0 ? WO_1IN : WO_2IN)), M, 2 * DFF, DM};
                pg8::StaticOrder S; S.init(M, 2 * DFF, (int)gridDim.x, (int)blockIdx.x);
                pg8::EpiSwiglu E{(bf16*)(ws + WS_H), SSb, {{0.f, 0.f, 0.f, 0.f}, {0.f, 0.f, 0.f, 0.f}}, -1};
#ifndef NO_SWIGLU
                pg8::gemm_phase<pg8::EpiSwiglu, pg8::StaticOrder, true, true, true>(lds, g, S, E);
#endif
            } else if (k == 1 || k == 4 || k == 7 || k == 9) {
                const bf16* Aop = (k == 1 || k == 9) ? (const bf16*)(ws + WS_H) : (k == 4) ? (const bf16*)(ws + WS_OMIX) : (const bf16*)(ws + WS_OX);
                const bf16* Bop = (const bf16*)(wl + (k == 1 ? WO_1OUT : k == 9 ? WO_2OUT : k == 4 ? WO_MIXOUT : WO_XO));
                const int Kd = (k == 1 || k == 9) ? DFF : DM;
                pg8::Gemm g{Aop, Bop, M, DM, Kd};
                pg8::StaticOrder S; S.init(M, DM, (int)gridDim.x, (int)blockIdx.x);
                const bool fin = (l == DEPTH - 1 && k == 9), pre = (l == DEPTH - 1 && k == 7);
                pg8::EpiResid E{fin ? (const _Float16*)(ws + WS_OMIX) : (const _Float16*)outp, pre ? (_Float16*)(ws + WS_OMIX) : (_Float16*)outp, nullptr, SSb, A.zero_alpha ? 0.0f : ((k == 1 || k == 9) ? 0.5f : 1.0f), fin ? outp : nullptr};
#ifndef NO_RESID
                pg8::gemm_phase<pg8::EpiResid, pg8::StaticOrder, true, true>(lds, g, S, E);
#endif
            } else if (k == 2 || k == 5) {
                const int nrep = (k == 5) ? 2 : 1;
                for (int rep = 0; rep < nrep; ++rep) {
                    pg8::Gemm g; pg8::EpiProj E; int Md, Nd;
                    if (k == 2) { Md = M; Nd = even ? 3328 : 3072; g = pg8::Gemm{XB, (const bf16*)(wl + WO_MIXIN), Md, Nd, DM};
                        E = pg8::EpiProj{(bf16*)(ws + WS_P), PP, SSb, even ? 9 : 10, (bf16*)(ws + WS_VT), 11, 9, {{0.f, 0.f, 0.f, 0.f}, {0.f, 0.f, 0.f, 0.f}}, -1}; }
                    else if (rep == 0) { Md = M; Nd = DM; g = pg8::Gemm{XB, (const bf16*)(wl + WO_XQ), Md, Nd, DM};
                        E = pg8::EpiProj{(bf16*)(ws + WS_QX), DM, SSb, 4, nullptr, 11, 9, {{0.f, 0.f, 0.f, 0.f}, {0.f, 0.f, 0.f, 0.f}}, -1}; }
                    else { Md = MMEM; Nd = 2 * DM; g = pg8::Gemm{(const bf16*)(ws + WS_MEMB), (const bf16*)(ws + WS_WKV) + (size_t)l * 2048 * DM, Md, Nd, DM};
                        E = pg8::EpiProj{(bf16*)(ws + WS_KX), DM, (const float*)(ws + WS_SSMEM), 4, (bf16*)(ws + WS_VXT), 8, 10, {{0.f, 0.f, 0.f, 0.f}, {0.f, 0.f, 0.f, 0.f}}, -1}; }
                    pg8::StaticOrder S; S.init(Md, Nd, (int)gridDim.x, (int)blockIdx.x);
#ifndef NO_PROJ
                    pg8::gemm_phase<pg8::EpiProj, pg8::StaticOrder, true, true, true>(lds, g, S, E);
#endif
                    __syncthreads();
                }
            } else if (k == 100) {
                kprep_phase(ws, tid, even ? 0 : 1, even ? I.e_qkg + (size_t)(l >> 1) * 256 : I.o_qkg + (size_t)(l >> 1) * 128, nullptr);
            } else if (k == 101) {
                kprep_phase(ws, tid, 2, I.xqkg + (size_t)l * 512, nullptr);
            } else if (k == 3) {
                #ifndef NO_EVEN
                if (even) attn_even_phase(I, ws, lds, tid, l, outp + (size_t)32 * MiB);
#endif
#ifndef NO_ODD
                if (!even) attn_odd_phase(I, ws, lds, tid, l);
#endif
            } else {
#ifndef NO_CROSS
                attn_cross_phase(I, ws, lds, tid, l);
#endif
            }
        }
        if (ph + 1 < A.ph_hi) { if (ph == 0) cg::this_grid().sync(); else xcd_barrier(xbar); }
    }
}

extern "C" void kernel_launch(void* const* d_in, const int* in_sizes, int n_in, void* d_out, int out_size, void* d_ws, size_t ws_size, hipStream_t stream) {
    static int grid = 0;
    if (grid == 0) {
        if (n_in != 23 || out_size != M * DM || ws_size < WS_END) { fprintf(stderr, "kernel_launch: unexpected shapes (n_in %d out %d ws %zu)\n", n_in, out_size, ws_size); grid = -1; return; }
        int dev = 0, cus = 0, per_cu = 0;
        hipGetDevice(&dev); hipDeviceGetAttribute(&cus, hipDeviceAttributeMultiprocessorCount, dev);
        if (hipFuncSetAttribute((const void*)mega_fwd, hipFuncAttributeMaxDynamicSharedMemorySize, LDS_BYTES) != hipSuccess) { fprintf(stderr, "kernel_launch: hipFuncSetAttribute failed\n"); grid = -1; return; }
        if (hipOccupancyMaxActiveBlocksPerMultiprocessor(&per_cu, (const void*)mega_fwd, NTHREADS, LDS_BYTES) != hipSuccess || per_cu < 1) { fprintf(stderr, "kernel_launch: occupancy query says %d\n", per_cu); per_cu = 1; }
        (void)hipGetLastError();
        grid = cus * per_cu; if (grid > 256) grid = 256;
        fprintf(stderr, "kernel_launch: grid %d (cus %d x %d)\n", grid, cus, per_cu);
    }
    if (grid < 0) return;
    (void)hipMemsetAsync(d_ws, 0, 16384, stream);
    Args a{};
    for (int i = 0; i < 23; ++i) a.in[i] = (const float*)d_in[i];
    a.out = (float*)d_out; a.ws = (unsigned char*)d_ws;
    for (int i = 0; i < 8; ++i) a.inv[i] = std::pow(500000.0, -(double)i / 8.0);
    const int NPH = 1 + 12 * DEPTH;
#if MK_SINGLE
    a.ph_lo = 0; a.ph_hi = NPH;
    void* args[] = {&a};
    hipError_t e = hipLaunchCooperativeKernel((const void*)mega_fwd, dim3(grid), dim3(NTHREADS), args, LDS_BYTES, stream);
    if (e != hipSuccess) fprintf(stderr, "cooperative launch failed: %s (grid %d)\n", hipGetErrorString(e), grid);
#else
#ifndef REP_MASK
#define REP_MASK 0
#endif
    for (int ph = 0; ph < NPH; ++ph) { a.ph_lo = ph; a.ph_hi = ph + 1;
        const int kq_ = (ph == 0) ? -1 : (ph - 1) % 12; const int kk = (kq_ < 0) ? -1 : (kq_ <= 2) ? kq_ : (kq_ == 3) ? 100 : (kq_ <= 6) ? kq_ - 1 : (kq_ == 7) ? 101 : kq_ - 2; int nrun = 1;
        if (((REP_MASK & 1) && (kk == 0 || kk == 8)) || ((REP_MASK & 2) && kk == 2) || ((REP_MASK & 4) && kk == 3) || ((REP_MASK & 8) && kk == 5) || ((REP_MASK & 16) && kk == 6) || ((REP_MASK & 32) && ph == 0) || ((REP_MASK & 512) && (kk == 100 || kk == 101)) || ((REP_MASK & 64) && kk == 3 && (((ph - 1) / 12) & 1) == 0) || ((REP_MASK & 128) && kk == 3 && (((ph - 1) / 12) & 1) == 1)) nrun = 2;
        if ((REP_MASK & 256) && (kk == 1 || kk == 4 || kk == 7 || kk == 9)) { a.zero_alpha = 1; hipLaunchKernelGGL(mega_fwd, dim3(grid), dim3(NTHREADS), LDS_BYTES, stream, a); a.zero_alpha = 0; }
        for (int r = 0; r < nrun; ++r) hipLaunchKernelGGL(mega_fwd, dim3(grid), dim3(NTHREADS), LDS_BYTES, stream, a); }
#endif
}
```
